# Optimizing an MI355X kernel written in HIP

```python
import jax, jax.numpy as jnp
from jax import lax
import numpy as np

D_MODEL = 1024
BATCH = 8
SEQ = 8192
DEPTH = 4

GLA_HEADS = 4
GLA_DK = 64
GLA_DV = 128
GLA_GATE_RANK = 16
GLA_TAU = 16.0
GLA_CHUNK = 64
CONV_CH = D_MODEL // 2
CONV_WIDTH = 31
EVEN_SPLITS = (GLA_HEADS * GLA_DK, GLA_HEADS * GLA_DK, GLA_HEADS * GLA_DV, GLA_HEADS * GLA_DV, GLA_GATE_RANK, 2 * CONV_CH)
EVEN_IN = sum(EVEN_SPLITS)
EVEN_MIX = GLA_HEADS * GLA_DV + CONV_CH
ATTN_HEADS = 16
HEAD_DIM = D_MODEL // ATTN_HEADS
DILATED_BRANCHES = ((128, 1), (512, 4), (2048, 16))
DIL_BLOCK = 128
ROPE_DIMS = HEAD_DIM // 4
ROPE_THETA = 500000.0
N_GROUPS = 4
EXPERTS_PER_GROUP = 8
N_EXPERTS = N_GROUPS * EXPERTS_PER_GROUP
TOP_K = 2
EXPERT_HIDDEN = 512
MOE_BLOCK = 128
ADA_CHUNKS = 6
NORM_EPS = 1e-6

kernel_name = 'hybrid_gla_conv_dilated_hmoe_trunk'


def rms_norm(x, g):
    x32 = x.astype(jnp.float32)
    y = x32 * lax.rsqrt(jnp.mean(x32 * x32, axis=-1, keepdims=True) + NORM_EPS)
    return (y * g.astype(jnp.float32)).astype(x.dtype)


def layer_norm(x, g, b):
    x32 = x.astype(jnp.float32)
    mu = jnp.mean(x32, axis=-1, keepdims=True)
    var = jnp.mean(jnp.square(x32 - mu), axis=-1, keepdims=True)
    y = (x32 - mu) * lax.rsqrt(var + NORM_EPS) * g.astype(jnp.float32) + b.astype(jnp.float32)
    return y.astype(x.dtype)


def modulate(x, g, shift, scale):
    return rms_norm(x, g) * (1 + scale[:, None, :]) + shift[:, None, :]


def gla_chunked(q, k, v, log_a):
    B, S, H, DK = q.shape
    DV = v.shape[-1]
    C = GLA_CHUNK
    N = S // C

    def blocks(t):
        return t.reshape(B, N, C, H, t.shape[-1]).transpose(0, 3, 1, 2, 4)

    q, k, v, log_a = blocks(q), blocks(k), blocks(v), blocks(log_a)
    b = jnp.cumsum(log_a, axis=3)
    b_last = b[:, :, :, -1:, :]
    q_dec = q * jnp.exp(b)
    k_dec = k * jnp.exp(-b)
    causal = jnp.tril(jnp.ones((C, C), dtype=bool))
    att = jnp.where(causal, jnp.einsum('bhnik,bhnjk->bhnij', q_dec, k_dec), 0.0)
    o_intra = jnp.einsum('bhnij,bhnjv->bhniv', att, v)
    chunk_kv = jnp.einsum('bhnjk,bhnjv->bhnkv', k * jnp.exp(b_last - b), v)
    decay = jnp.exp(b_last[:, :, :, 0, :])

    def step(state, inp):
        dec, kv = inp
        return dec[..., None] * state + kv, state

    init = jnp.zeros((B, H, DK, DV), jnp.float32)
    _, states = lax.scan(step, init, (jnp.moveaxis(decay, 2, 0), jnp.moveaxis(chunk_kv, 2, 0)))
    states = jnp.moveaxis(states, 0, 2)
    o = o_intra + jnp.einsum('bhnik,bhnkv->bhniv', q_dec, states)
    return o.transpose(0, 2, 3, 1, 4).reshape(B, S, H, DV)


def even_mixer(h, w_in, w_gate2, b_gate, gla_norm_g, conv_w, conv_b, conv_ln_g, conv_ln_b, w_out):
    B, S, _ = h.shape
    f32 = jnp.float32
    z = h @ w_in
    q, k, v, g, a_lr, u = jnp.split(z, [int(i) for i in np.cumsum(EVEN_SPLITS)[:-1]], axis=-1)
    q = q.reshape(B, S, GLA_HEADS, GLA_DK).astype(f32) * (GLA_DK ** -0.5)
    k = k.reshape(B, S, GLA_HEADS, GLA_DK).astype(f32)
    v = v.reshape(B, S, GLA_HEADS, GLA_DV).astype(f32)
    log_a = jax.nn.log_sigmoid((a_lr @ w_gate2).astype(f32) + b_gate.astype(f32)) / GLA_TAU
    log_a = log_a.reshape(B, S, GLA_HEADS, GLA_DK)
    o = gla_chunked(q, k, v, log_a)
    o = rms_norm(o, gla_norm_g).reshape(B, S, GLA_HEADS * GLA_DV)
    o_gla = o * jax.nn.silu(g.astype(f32))
    u_a, u_b = jnp.split(u, 2, axis=-1)
    glu = u_a * jax.nn.sigmoid(u_b)
    y = lax.conv_general_dilated(glu, conv_w.astype(glu.dtype)[:, None, :], window_strides=(1,),
                                 padding=((CONV_WIDTH - 1, 0),),
                                 dimension_numbers=('NWC', 'WIO', 'NWC'),
                                 feature_group_count=CONV_CH)
    y = jax.nn.silu(layer_norm(y + conv_b, conv_ln_g, conv_ln_b))
    mix = jnp.concatenate([o_gla.astype(h.dtype), y.astype(h.dtype)], axis=-1)
    return mix @ w_out


def partial_rope(t, positions):
    t = t.astype(jnp.float32)
    half = ROPE_DIMS // 2
    inv_freq = ROPE_THETA ** (-jnp.arange(0, ROPE_DIMS, 2, dtype=jnp.float32) / ROPE_DIMS)
    ang = positions.astype(jnp.float32)[..., None] * inv_freq
    cos = jnp.cos(ang)[:, :, None, :]
    sin = jnp.sin(ang)[:, :, None, :]
    t1 = t[..., :half]
    t2 = t[..., half:ROPE_DIMS]
    return jnp.concatenate([t1 * cos - t2 * sin, t2 * cos + t1 * sin, t[..., ROPE_DIMS:]], axis=-1)


def dilated_branch(q, k, v, window, dilation):
    B, S, H, Dh = q.shape
    steps = window // dilation
    unit = dilation * DIL_BLOCK
    s_pad = -(-S // unit) * unit
    L = s_pad // dilation
    nb = L // DIL_BLOCK

    def to_blocks(t):
        t = jnp.pad(t, ((0, 0), (0, s_pad - S), (0, 0), (0, 0)))
        t = t.reshape(B, L, dilation, H, Dh).transpose(0, 2, 3, 1, 4)
        return t.reshape(B, dilation, H, nb, DIL_BLOCK, Dh)

    def with_prev(t):
        prev = jnp.pad(t[:, :, :, :-1], ((0, 0), (0, 0), (0, 0), (1, 0), (0, 0), (0, 0)))
        return jnp.concatenate([prev, t], axis=4)

    qb = to_blocks(q)
    kc = with_prev(to_blocks(k))
    vc = with_prev(to_blocks(v))
    s = jnp.einsum('brhnqd,brhnkd->brhnqk', qb, kc) * (Dh ** -0.5)
    qi = jnp.arange(DIL_BLOCK)[:, None]
    kj = jnp.arange(2 * DIL_BLOCK)[None, :]
    dist = qi + DIL_BLOCK - kj
    band = (dist >= 0) & (dist <= steps)
    has_prev = (jnp.arange(nb) > 0)[:, None, None] | (kj >= DIL_BLOCK)[None]
    mask = band[None] & has_prev
    s = jnp.where(mask, s, -jnp.inf)
    m = jnp.max(s, axis=-1, keepdims=True)
    p = jnp.exp(s - m)
    l = jnp.sum(p, axis=-1, keepdims=True)
    o = jnp.einsum('brhnqk,brhnkd->brhnqd', p, vc) / l
    lse = (m + jnp.log(l))[..., 0]
    o = o.reshape(B, dilation, H, L, Dh).transpose(0, 3, 1, 2, 4).reshape(B, s_pad, H, Dh)[:, :S]
    lse = lse.reshape(B, dilation, H, L).transpose(0, 3, 1, 2).reshape(B, s_pad, H)[:, :S]
    return o, lse


def odd_mixer(h, positions, w_qkv, w_out):
    B, S, _ = h.shape
    q, k, v = jnp.split(h @ w_qkv, 3, axis=-1)
    q = partial_rope(q.reshape(B, S, ATTN_HEADS, HEAD_DIM), positions)
    k = partial_rope(k.reshape(B, S, ATTN_HEADS, HEAD_DIM), positions)
    v = v.reshape(B, S, ATTN_HEADS, HEAD_DIM).astype(jnp.float32)
    outs, lses = [], []
    for window, dilation in DILATED_BRANCHES:
        o_i, lse_i = dilated_branch(q, k, v, window, dilation)
        outs.append(o_i)
        lses.append(lse_i)
    wts = jax.nn.softmax(jnp.stack(lses, axis=0), axis=0)
    o = jnp.einsum('ibsh,ibshd->bshd', wts, jnp.stack(outs, axis=0))
    return o.reshape(B, S, ATTN_HEADS * HEAD_DIM).astype(h.dtype) @ w_out


def hier_moe(h, w_grp, b_grp, w_rt, b_rt, w1, w3, w2):
    B, S, D = h.shape
    T = B * S
    ht = h.reshape(T, D)
    tok = jnp.arange(T)
    g_logits = (ht @ w_grp).astype(jnp.float32) + b_grp.astype(jnp.float32)
    g_idx = jnp.argmax(g_logits, axis=-1)
    g_w = jax.nn.softmax(g_logits, axis=-1)[tok, g_idx]
    e_logits = ((ht @ w_rt).astype(jnp.float32) + b_rt.astype(jnp.float32)).reshape(T, N_GROUPS, EXPERTS_PER_GROUP)
    e_in_grp = e_logits[tok, g_idx]
    top_v, top_i = lax.top_k(e_in_grp, TOP_K)
    top_w = jax.nn.softmax(top_v, axis=-1) * g_w[:, None]
    e_flat = (g_idx[:, None] * EXPERTS_PER_GROUP + top_i).reshape(-1).astype(jnp.int32)
    w_flat = top_w.reshape(-1)
    tok_flat = jnp.repeat(tok, TOP_K).astype(jnp.int32)
    A = T * TOP_K
    order = jnp.argsort(e_flat)
    e_sorted = e_flat[order]
    counts = jnp.bincount(e_flat, length=N_EXPERTS)
    padded = (counts + MOE_BLOCK - 1) // MOE_BLOCK * MOE_BLOCK
    starts = jnp.cumsum(counts) - counts
    pends = jnp.cumsum(padded)
    pstarts = pends - padded
    dest = pstarts[e_sorted] + (jnp.arange(A) - starts[e_sorted])
    P = A + N_EXPERTS * MOE_BLOCK
    row_tok = jnp.full((P,), T, jnp.int32).at[dest].set(tok_flat[order])
    row_w = jnp.zeros((P,), jnp.float32).at[dest].set(w_flat[order])
    n_blk = P // MOE_BLOCK
    blk_e = jnp.clip(jnp.searchsorted(pends, jnp.arange(n_blk) * MOE_BLOCK, side='right'), 0, N_EXPERTS - 1)
    h_pad = jnp.concatenate([ht, jnp.zeros((1, D), ht.dtype)], axis=0)
    xs = h_pad[row_tok].reshape(n_blk, MOE_BLOCK, D)

    def expert_block(args):
        xb, e = args
        return (jax.nn.silu(xb @ w1[e]) * (xb @ w3[e])) @ w2[e]

    ys = lax.map(expert_block, (xs, blk_e)).reshape(P, D)
    out = jnp.zeros((T + 1, D), jnp.float32).at[row_tok].add(ys.astype(jnp.float32) * row_w[:, None])
    return out[:T].reshape(B, S, D).astype(h.dtype)


def setup_inputs(seed: int = 0) -> dict:
    key = jax.random.key(seed)
    ks = jax.random.split(key, 32)
    f32 = jnp.float32
    n_even = (DEPTH + 1) // 2
    n_odd = DEPTH // 2
    D = D_MODEL

    def nrm(k, shape, scale):
        return jax.random.normal(k, shape, f32) * scale

    offsets = jax.random.randint(ks[2], (BATCH, 1), 0, 4096, dtype=jnp.int32)
    positions = (offsets + jnp.arange(SEQ, dtype=jnp.int32)[None, :]).astype(jnp.int32)
    return {
        'x': nrm(ks[0], (BATCH, SEQ, D), 1.0),
        'c': nrm(ks[1], (BATCH, D), 1.0),
        'positions': positions,
        'ada_w': nrm(ks[3], (DEPTH, D, ADA_CHUNKS * D), 0.5 * D ** -0.5),
        'ada_b': nrm(ks[4], (DEPTH, ADA_CHUNKS * D), 0.02),
        'norm1_g': 1.0 + nrm(ks[5], (DEPTH, D), 0.02),
        'norm2_g': 1.0 + nrm(ks[6], (DEPTH, D), 0.02),
        'even_w_in': nrm(ks[7], (n_even, D, EVEN_IN), D ** -0.5),
        'even_w_gate2': nrm(ks[8], (n_even, GLA_GATE_RANK, GLA_HEADS * GLA_DK), GLA_GATE_RANK ** -0.5),
        'even_b_gate': nrm(ks[9], (n_even, GLA_HEADS * GLA_DK), 0.1),
        'even_gla_norm_g': 1.0 + nrm(ks[10], (n_even, GLA_DV), 0.02),
        'even_conv_w': nrm(ks[11], (n_even, CONV_WIDTH, CONV_CH), CONV_WIDTH ** -0.5),
        'even_conv_b': nrm(ks[12], (n_even, CONV_CH), 0.02),
        'even_conv_ln_g': 1.0 + nrm(ks[13], (n_even, CONV_CH), 0.02),
        'even_conv_ln_b': nrm(ks[14], (n_even, CONV_CH), 0.02),
        'even_w_out': nrm(ks[15], (n_even, EVEN_MIX, D), EVEN_MIX ** -0.5),
        'odd_w_qkv': nrm(ks[16], (n_odd, D, 3 * ATTN_HEADS * HEAD_DIM), D ** -0.5),
        'odd_w_out': nrm(ks[17], (n_odd, ATTN_HEADS * HEAD_DIM, D), (ATTN_HEADS * HEAD_DIM) ** -0.5),
        'moe_w_grp': nrm(ks[18], (DEPTH, D, N_GROUPS), D ** -0.5),
        'moe_b_grp': nrm(ks[19], (DEPTH, N_GROUPS), 0.01),
        'moe_w_rt': nrm(ks[20], (DEPTH, D, N_EXPERTS), D ** -0.5),
        'moe_b_rt': nrm(ks[21], (DEPTH, N_EXPERTS), 0.01),
        'moe_w1': nrm(ks[22], (DEPTH, N_EXPERTS, D, EXPERT_HIDDEN), D ** -0.5),
        'moe_w3': nrm(ks[23], (DEPTH, N_EXPERTS, D, EXPERT_HIDDEN), D ** -0.5),
        'moe_w2': nrm(ks[24], (DEPTH, N_EXPERTS, EXPERT_HIDDEN, D), EXPERT_HIDDEN ** -0.5),
        'final_norm_g': 1.0 + nrm(ks[25], (D,), 0.02),
    }


def reference(x, c, positions, ada_w, ada_b, norm1_g, norm2_g, even_w_in, even_w_gate2, even_b_gate,
              even_gla_norm_g, even_conv_w, even_conv_b, even_conv_ln_g, even_conv_ln_b, even_w_out,
              odd_w_qkv, odd_w_out, moe_w_grp, moe_b_grp, moe_w_rt, moe_b_rt, moe_w1, moe_w3, moe_w2,
              final_norm_g):
    cond = jax.nn.silu(c)
    for layer in range(DEPTH):
        mod = cond.astype(ada_w.dtype) @ ada_w[layer] + ada_b[layer]
        sh1, sc1, g1, sh2, sc2, g2 = jnp.split(mod, ADA_CHUNKS, axis=-1)
        h = modulate(x, norm1_g[layer], sh1, sc1)
        i = layer // 2
        if layer % 2 == 0:
            y = even_mixer(h, even_w_in[i], even_w_gate2[i], even_b_gate[i], even_gla_norm_g[i],
                           even_conv_w[i], even_conv_b[i], even_conv_ln_g[i], even_conv_ln_b[i],
                           even_w_out[i])
        else:
            y = odd_mixer(h, positions, odd_w_qkv[i], odd_w_out[i])
        x = x + (g1[:, None, :] * y).astype(x.dtype)
        h = modulate(x, norm2_g[layer], sh2, sc2)
        y = hier_moe(h, moe_w_grp[layer], moe_b_grp[layer], moe_w_rt[layer], moe_b_rt[layer],
                     moe_w1[layer], moe_w3[layer], moe_w2[layer])
        x = x + (g2[:, None, :] * y).astype(x.dtype)
    return rms_norm(x, final_norm_g)
```

```cpp
#include <hip/hip_runtime.h>
#include <cstdio>
#include <cstdint>
namespace pg8 {
#define PG8_LAS __attribute__((address_space(3)))
typedef unsigned short bf16_t;
typedef short bf16x8 __attribute__((ext_vector_type(8)));
typedef float f32x4 __attribute__((ext_vector_type(4)));
typedef unsigned u32x4 __attribute__((ext_vector_type(4)));
constexpr int BM = 256, BK = 64, HALF = 128, HTB = HALF * BK * 2  , STAGE_BYTES = 8 * HTB, NXCD = 8, WGM = 8;

__host__ __device__ __forceinline__ int lds_byte(int r, int c) { const int st = (r >> 4) * 2 + (c >> 5), rr = r & 15, cc = c & 31, ob = rr * 64 + cc * 2; return st * 1024 + (ob ^ (((ob >> 9) & 1) << 5)); }
__host__ __device__ __forceinline__ void stage_rc(int b, int& R, int& C) { const int st = b / 1024, sb = b % 1024, swz = sb ^ (((sb >> 9) & 1) << 5); R = (st >> 1) * 16 + swz / 64; C = (st & 1) * 32 + (swz % 64) / 2; }
__host__ __device__ __forceinline__ int perm32(int rho) { const int n = rho >> 4, i = rho & 15; return 8 * (i >> 2) + 4 * n + (i & 3); }

struct Unit { int pm, pn; };
struct Gemm { const bf16_t* A; const bf16_t* Bt; int M, N, K; };

struct StaticOrder {
    int nM, nN, nwg, G, c;
    __host__ __device__ void init(int M, int N, int G_, int c_) { nM = M / BM; nN = N / BM; nwg = nM * nN; G = G_; c = c_; }
    __host__ __device__ bool next(int i, Unit& u) const {
        const long L = (long)i * G + c; if (L >= nwg) return false;
        int wgid = (int)L; { const int q = nwg / NXCD, r = nwg % NXCD, xcd = wgid % NXCD, off = wgid / NXCD; wgid = (xcd < r ? xcd * (q + 1) : r * (q + 1) + (xcd - r) * q) + off; }
        const int nig = WGM * nN, gid = wgid / nig, fm = gid * WGM, gsz = (nM - fm) < WGM ? (nM - fm) : WGM;
        u.pm = fm + ((wgid % nig) % gsz); u.pn = (wgid % nig) / gsz; return true;
    }
    __device__ __forceinline__ void a_ready(const Unit&) const {}
    __device__ __forceinline__ void done(const Unit&) const {}
};

__device__ __forceinline__ unsigned cvt_pk_bf16(float lo, float hi) { unsigned r; asm volatile("v_cvt_pk_bf16_f32 %0, %1, %2" : "=v"(r) : "v"(lo), "v"(hi)); return r; }
typedef float f32x2 __attribute__((ext_vector_type(2)));
__device__ __forceinline__ float fast_exp(float x) { return __builtin_amdgcn_exp2f(x * 1.4426950408889634f); }
__device__ __forceinline__ float fast_silu(float x) { return x * __builtin_amdgcn_rcpf(1.0f + fast_exp(-x)); }

struct EpiStore {
    static constexpr bool PERM = true, AFTER_DRAIN = false;
    bf16_t* O; int ldc; int nN;
    __device__ __forceinline__ void operator()(const f32x4 (&acc)[2][2][4][2], const Unit& u, int wr, int wc, int fr, int fq) const {
        const int row0 = u.pm * BM + wr * 64 + fr; const int col0 = (u.pn % nN) * BM + wc * 32 + 8 * fq;
#pragma unroll
        for (int ai = 0; ai < 2; ++ai)
#pragma unroll
            for (int m = 0; m < 4; ++m) { bf16_t* rowp = O + (size_t)(row0 + ai * HALF + m * 16) * ldc + col0;
#pragma unroll
                for (int bj = 0; bj < 2; ++bj) { const f32x4 v0 = acc[ai][bj][m][0], v1 = acc[ai][bj][m][1];
                    u32x4 w; w.x = cvt_pk_bf16(v0[0], v0[1]); w.y = cvt_pk_bf16(v0[2], v0[3]); w.z = cvt_pk_bf16(v1[0], v1[1]); w.w = cvt_pk_bf16(v1[2], v1[3]);
                    *(u32x4*)(rowp + bj * HALF) = w; } }
    }
};

struct EpiQkv {
    static constexpr bool PERM = true, AFTER_DRAIN = false;
    bf16_t* O; int ldc; const float* cs;
    __device__ __forceinline__ void operator()(const f32x4 (&acc)[2][2][4][2], const Unit& u, int wr, int wc, int fr, int fq) const {
        const int row0 = u.pm * BM + wr * 64 + fr; const int col0 = u.pn * BM + wc * 32 + 8 * fq;
        const bool roped = (u.pn < 8) && ((wc & 1) == 0);
        const float qs = (u.pn < 4) ? 0.125f : 1.0f;
        const float sgn = (fq == 0) ? -1.0f : 1.0f;
#pragma unroll
        for (int ai = 0; ai < 2; ++ai)
#pragma unroll
            for (int m = 0; m < 4; ++m) { const int row = row0 + ai * HALF + m * 16; bf16_t* rowp = O + (size_t)row * ldc + col0;
                f32x4 c0 = {1.f, 1.f, 1.f, 1.f}, c1 = c0, s0 = {0.f, 0.f, 0.f, 0.f}, s1 = s0;
                if (roped) { const f32x4* cp = (const f32x4*)(cs + (size_t)row * 16); c0 = cp[0]; c1 = cp[1]; s0 = cp[2]; s1 = cp[3]; }
#pragma unroll
                for (int bj = 0; bj < 2; ++bj) { f32x4 v0 = acc[ai][bj][m][0], v1 = acc[ai][bj][m][1];
                    if (roped) {
                        f32x4 p0, p1;
#pragma unroll
                        for (int i = 0; i < 4; ++i) { p0[i] = __shfl_xor(v0[i], 16); p1[i] = __shfl_xor(v1[i], 16); }
                        if (fq < 2) { v0 = v0 * c0 + (p0 * s0) * sgn; v1 = v1 * c1 + (p1 * s1) * sgn; }
                    }
                    v0 = v0 * qs; v1 = v1 * qs;
                    u32x4 w; w.x = cvt_pk_bf16(v0[0], v0[1]); w.y = cvt_pk_bf16(v0[2], v0[3]); w.z = cvt_pk_bf16(v1[0], v1[1]); w.w = cvt_pk_bf16(v1[2], v1[3]);
                    *(u32x4*)(rowp + bj * HALF) = w; } }
    }
};

struct EpiSwiglu {
    static constexpr bool PERM = true, AFTER_DRAIN = false;
    bf16_t* O;
    __device__ __forceinline__ void operator()(const f32x4 (&acc)[2][2][4][2], const Unit& u, int wr, int wc, int fr, int fq) const {
        const int row0 = u.pm * BM + wr * 64 + fr; const int col0 = (u.pn & 3) * 128 + wc * 32 + 8 * fq;
#pragma unroll
        for (int ai = 0; ai < 2; ++ai)
#pragma unroll
            for (int m = 0; m < 4; ++m) { bf16_t* rowp = O + (size_t)(row0 + ai * HALF + m * 16) * 512 + col0;
                const f32x4 a0 = acc[ai][0][m][0], a1 = acc[ai][0][m][1], b0 = acc[ai][1][m][0], b1 = acc[ai][1][m][1];
                f32x4 h0, h1;
#pragma unroll
                for (int i = 0; i < 4; ++i) { h0[i] = fast_silu(a0[i]) * b0[i]; h1[i] = fast_silu(a1[i]) * b1[i]; }
                u32x4 w; w.x = cvt_pk_bf16(h0[0], h0[1]); w.y = cvt_pk_bf16(h0[2], h0[3]); w.z = cvt_pk_bf16(h1[0], h1[1]); w.w = cvt_pk_bf16(h1[2], h1[3]);
                *(u32x4*)rowp = w; }
    }
};

struct GroupOrder {
    const PG8_LAS int* tstart; int G, v;
    __device__ __forceinline__ bool next(int i, Unit& u) const {
        const int L = i * G + v; const int nt = tstart[32];
        if (L >= nt * 4) return false;
        const int pm = L >> 2; int e = 0;
#pragma unroll
        for (int k = 1; k < 32; ++k) e += (tstart[k] <= pm) ? 1 : 0;
        u.pm = pm; u.pn = e * 4 + (L & 3); return true;
    }
    __device__ __forceinline__ void a_ready(const Unit&) const {}
    __device__ __forceinline__ void done(const Unit&) const {}
};

template <class Epi, class Sched, bool ALIGN_EPI = false, bool SP2 = false>
__device__ __forceinline__ void gemm_phase(PG8_LAS unsigned char* lds, const Gemm g, const Sched& S, const Epi& E) {
    int tid_ = threadIdx.x; asm volatile("" : "+v"(tid_));
    const int tid = tid_, wid = __builtin_amdgcn_readfirstlane(tid >> 6), lane = tid & 63, wr = wid >> 2, wc = wid & 3, fr = lane & 15, fq = lane >> 4;
    const int K = g.K, nt = K / BK;
    unsigned voffA[2], voffB[2];
#pragma unroll
    for (int i = 0; i < 2; ++i) { int R, C; stage_rc(tid * 16 + i * 8192, R, C); const int Rb = Epi::PERM ? ((R & ~31) + perm32(R & 31)) : R;
        voffA[i] = (unsigned)(R * K + C) * 2u; voffB[i] = (unsigned)(Rb * K + C) * 2u; }
    const size_t kstep = (size_t)(BK * 2);
    const size_t hstep = (size_t)HALF * K * 2;
    const size_t tstep = 2 * hstep;
    const unsigned ldsw = (unsigned)wid * 1024u;
    const int aoff = lds_byte(wr * 64 + fr, fq * 8), boff = lds_byte(wc * 32 + fr, fq * 8);
#define PG8_SA(b, h) (((b) * 2 + (h)) * HTB)
#define PG8_SB(b, h) ((4 + (b) * 2 + (h)) * HTB)
#define PG8_STAGE(bufoff, gbase, voff) do { _Pragma("unroll") for (int _i = 0; _i < 2; ++_i) \
        __builtin_amdgcn_global_load_lds((const unsigned*)((const char*)(gbase) + (voff)[_i]), (PG8_LAS unsigned*)(lds + (bufoff) + ldsw + _i * 8192), 16, 0, 0); } while (0)
#define PG8_LDA(dst, b, h) do { _Pragma("unroll") for (int m = 0; m < 4; ++m) _Pragma("unroll") for (int k = 0; k < 2; ++k) dst[m][k] = *(const PG8_LAS bf16x8*)(lds + PG8_SA(b, h) + aoff + m * 2048 + k * 1024); } while (0)
#define PG8_LDB(dst, b, h) do { _Pragma("unroll") for (int n = 0; n < 2; ++n) _Pragma("unroll") for (int k = 0; k < 2; ++k) dst[n][k] = *(const PG8_LAS bf16x8*)(lds + PG8_SB(b, h) + boff + n * 2048 + k * 1024); } while (0)
#define PG8_MMA(ai, bj, At, Bt) do { __builtin_amdgcn_s_setprio(1); _Pragma("unroll") for (int m = 0; m < 4; ++m) _Pragma("unroll") for (int n = 0; n < 2; ++n) _Pragma("unroll") for (int k = 0; k < 2; ++k) \
        acc[ai][bj][m][n] = __builtin_amdgcn_mfma_f32_16x16x32_bf16(Bt[n][k], At[m][k], acc[ai][bj][m][n], 0, 0, 0); __builtin_amdgcn_s_setprio(0); } while (0)
#define PG8_WAIT_V(n) asm volatile("s_waitcnt vmcnt(" #n ")" ::: "memory")
#define PG8_WAIT_L(n) asm volatile("s_waitcnt lgkmcnt(" #n ")" ::: "memory")
#define PG8_BAR __builtin_amdgcn_s_barrier()
#define PG8_SCHED __builtin_amdgcn_sched_barrier(0)
    Unit cur, nxt; int ui = 0;
    if (!S.next(0, cur)) return;
    f32x4 acc[2][2][4][2];
#pragma unroll
    for (int a = 0; a < 2; ++a)
#pragma unroll
        for (int b = 0; b < 2; ++b)
#pragma unroll
            for (int m = 0; m < 4; ++m)
#pragma unroll
                for (int n = 0; n < 2; ++n) acc[a][b][m][n] = (f32x4){0.f, 0.f, 0.f, 0.f};
    bf16x8 At[4][2], B0[2][2], B1[2][2];
    const char* cA = (const char*)g.A + (size_t)cur.pm * tstep; const char* cB = (const char*)g.Bt + (size_t)cur.pn * tstep;
    S.a_ready(cur);
    if constexpr (SP2) {
        PG8_STAGE(PG8_SB(0, 0), cB, voffB); PG8_STAGE(PG8_SB(0, 1), cB + hstep, voffB); PG8_STAGE(PG8_SA(0, 0), cA, voffA); PG8_STAGE(PG8_SA(0, 1), cA + hstep, voffA);
        if (wr == 1) PG8_BAR;
        PG8_WAIT_V(2); PG8_BAR;
        PG8_STAGE(PG8_SB(1, 0), cB + kstep, voffB); PG8_STAGE(PG8_SA(1, 0), cA + kstep, voffA); PG8_STAGE(PG8_SB(1, 1), cB + hstep + kstep, voffB);
        PG8_WAIT_V(6); PG8_BAR;
    } else {
        PG8_STAGE(PG8_SB(0, 0), cB, voffB); PG8_STAGE(PG8_SA(0, 0), cA, voffA); PG8_STAGE(PG8_SB(0, 1), cB + hstep, voffB); PG8_STAGE(PG8_SA(0, 1), cA + hstep, voffA);
        if (wr == 1) PG8_BAR;
        PG8_WAIT_V(4); PG8_BAR;
        PG8_STAGE(PG8_SB(1, 0), cB + kstep, voffB); PG8_STAGE(PG8_SA(1, 0), cA + kstep, voffA); PG8_STAGE(PG8_SB(1, 1), cB + hstep + kstep, voffB);
        PG8_WAIT_V(6); PG8_BAR;
    }
    for (;;) {
        const bool has_next = S.next(ui + 1, nxt);
        const char* nA = has_next ? (const char*)g.A + (size_t)nxt.pm * tstep : cA; const char* nB = has_next ? (const char*)g.Bt + (size_t)nxt.pn * tstep : cB;
        for (int t = 0; t < nt; t += 2) {
            const bool last = (t == nt - 2);
            const char* a1 = cA + (size_t)(t + 1) * kstep;
            const char* a2 = last ? nA : cA + (size_t)(t + 2) * kstep; const char* b2 = last ? nB : cB + (size_t)(t + 2) * kstep;
            const char* a3 = a2 + kstep; const char* b3 = b2 + kstep;
            if (last && has_next) S.a_ready(nxt);
            if constexpr (SP2) {
            PG8_LDB(B0, 0, 0); PG8_LDB(B1, 0, 1); PG8_SCHED; PG8_LDA(At, 0, 0); PG8_STAGE(PG8_SA(1, 1), a1 + hstep, voffA);
            PG8_WAIT_V(8); PG8_WAIT_L(0); PG8_BAR; PG8_MMA(0, 0, At, B0); PG8_MMA(0, 1, At, B1); PG8_BAR; PG8_SCHED;
            PG8_LDA(At, 0, 1); PG8_STAGE(PG8_SB(0, 0), b2, voffB); PG8_STAGE(PG8_SB(0, 1), b2 + hstep, voffB); PG8_STAGE(PG8_SA(0, 0), a2, voffA);
            PG8_WAIT_V(8); PG8_WAIT_L(0); PG8_BAR; PG8_MMA(1, 0, At, B0); PG8_MMA(1, 1, At, B1); PG8_BAR; PG8_SCHED;
            PG8_LDB(B0, 1, 0); PG8_LDB(B1, 1, 1); PG8_SCHED; PG8_LDA(At, 1, 0); PG8_STAGE(PG8_SA(0, 1), a2 + hstep, voffA);
            PG8_WAIT_V(8); PG8_WAIT_L(0); PG8_BAR; PG8_MMA(0, 0, At, B0); PG8_MMA(0, 1, At, B1); PG8_BAR; PG8_SCHED;
            PG8_LDA(At, 1, 1); PG8_STAGE(PG8_SB(1, 0), b3, voffB); PG8_STAGE(PG8_SB(1, 1), b3 + hstep, voffB); PG8_STAGE(PG8_SA(1, 0), a3, voffA);
            PG8_WAIT_V(8); PG8_WAIT_L(0); PG8_BAR; PG8_MMA(1, 0, At, B0); PG8_MMA(1, 1, At, B1); PG8_BAR; PG8_SCHED;
            } else {
            PG8_LDB(B0, 0, 0); PG8_SCHED; PG8_LDA(At, 0, 0); PG8_STAGE(PG8_SA(1, 1), a1 + hstep, voffA);
            PG8_WAIT_L(8); PG8_BAR; PG8_WAIT_L(0); PG8_MMA(0, 0, At, B0); PG8_BAR; PG8_SCHED;
            PG8_LDB(B1, 0, 1); PG8_STAGE(PG8_SB(0, 0), b2, voffB);
            PG8_BAR; PG8_WAIT_L(0); PG8_MMA(0, 1, At, B1); PG8_BAR;
            PG8_LDA(At, 0, 1); PG8_STAGE(PG8_SA(0, 0), a2, voffA);
            PG8_BAR; PG8_WAIT_L(0); PG8_MMA(1, 0, At, B0); PG8_BAR; PG8_SCHED;
            PG8_STAGE(PG8_SB(0, 1), b2 + hstep, voffB);
            PG8_WAIT_V(6); PG8_BAR; PG8_MMA(1, 1, At, B1); PG8_BAR;
            PG8_LDB(B0, 1, 0); PG8_SCHED; PG8_LDA(At, 1, 0); PG8_STAGE(PG8_SA(0, 1), a2 + hstep, voffA);
            PG8_WAIT_L(8); PG8_BAR; PG8_WAIT_L(0); PG8_MMA(0, 0, At, B0); PG8_BAR; PG8_SCHED;
            PG8_LDB(B1, 1, 1); PG8_STAGE(PG8_SB(1, 0), b3, voffB);
            PG8_BAR; PG8_WAIT_L(0); PG8_MMA(0, 1, At, B1); PG8_BAR;
            PG8_LDA(At, 1, 1); PG8_STAGE(PG8_SA(1, 0), a3, voffA);
            PG8_BAR; PG8_WAIT_L(0); PG8_MMA(1, 0, At, B0); PG8_BAR; PG8_SCHED;
            PG8_STAGE(PG8_SB(1, 1), b3 + hstep, voffB);
            PG8_WAIT_V(6); PG8_BAR; PG8_MMA(1, 1, At, B1); PG8_BAR;
            }
        }
        if constexpr (ALIGN_EPI) { if (wr == 0) PG8_BAR; }
        if constexpr (!Epi::AFTER_DRAIN) { E(acc, cur, wr, wc, fr, fq); S.done(cur); }
        if (!has_next) break;
#pragma unroll
        for (int a = 0; a < 2; ++a)
#pragma unroll
            for (int b = 0; b < 2; ++b)
#pragma unroll
                for (int m = 0; m < 4; ++m)
#pragma unroll
                    for (int n = 0; n < 2; ++n) acc[a][b][m][n] = (f32x4){0.f, 0.f, 0.f, 0.f};
        cur = nxt; cA = nA; cB = nB; ++ui;
        if constexpr (ALIGN_EPI) { if (wr == 1) PG8_BAR; }
    }
    PG8_WAIT_V(0);
    if constexpr (!ALIGN_EPI) { if (wr == 0) PG8_BAR; }
    PG8_BAR;
    if constexpr (Epi::AFTER_DRAIN) { E.fused(acc, cur, wr, wc, fr, fq, lds, wid, lane); S.done(cur); }
#undef PG8_SA
#undef PG8_SB
#undef PG8_STAGE
#undef PG8_LDA
#undef PG8_LDB
#undef PG8_MMA
#undef PG8_WAIT_V
#undef PG8_WAIT_L
#undef PG8_BAR
#undef PG8_SCHED
}
}
typedef short v4i16_t __attribute__((ext_vector_type(4)));
#define GAS __attribute__((address_space(1)))
#define LAS __attribute__((address_space(3)))
typedef unsigned short bf16;
typedef unsigned v4u __attribute__((ext_vector_type(4)));
typedef float f32x4 __attribute__((ext_vector_type(4)));
typedef short bf16x8 __attribute__((ext_vector_type(8)));
typedef GAS unsigned gu32;
typedef GAS unsigned long long gu64;
#define RLX_AGENT __ATOMIC_RELAXED, __HIP_MEMORY_SCOPE_AGENT
#define LDS_WAIT() asm volatile("s_waitcnt lgkmcnt(0)" ::: "memory")
#define VM_WAIT() asm volatile("s_waitcnt vmcnt(0)" ::: "memory")
__device__ __forceinline__ unsigned long long rt() { return __builtin_amdgcn_s_memrealtime(); }
__device__ __forceinline__ unsigned f2bf(float f) { unsigned u = __builtin_bit_cast(unsigned, f); return (u + 0x7fffu + ((u >> 16) & 1u)) >> 16; }
__device__ __forceinline__ unsigned pk2(float lo, float hi) { return f2bf(lo) | (f2bf(hi) << 16); }

#define XB_TMO      128
#define XB_XCNT(j)  (256  + 64 * (j))
#define XB_XSUB(j)  (1280 + 64 * (j))
#define XB_XGEN(j)  (2304 + 64 * (j))
#define XB_TOP      3328
#define XB_TOPGEN   3392
#define XCD_BAR_WORDS 3456
#define XB_SPIN_CAP (1u << 18)

__device__ __forceinline__ unsigned xb_ld(unsigned* p)              { return __hip_atomic_load(p, __ATOMIC_RELAXED, __HIP_MEMORY_SCOPE_AGENT); }
__device__ __forceinline__ unsigned xb_add(unsigned* p, unsigned v) { return __hip_atomic_fetch_add(p, v, __ATOMIC_RELAXED, __HIP_MEMORY_SCOPE_AGENT); }
__device__ __forceinline__ unsigned xb_xcc_id() { return (unsigned)__builtin_amdgcn_s_getreg((3 << 11) | 20) & 0xFu; }
#define XB_SPIN(cond, bar) do { unsigned _sp = 0; while (cond) { __builtin_amdgcn_s_sleep(1); \
    if ((++_sp & 255u) == 0u) { if (xb_ld(&(bar)[XB_TMO])) break; if (_sp > XB_SPIN_CAP) { atomicAdd(&(bar)[XB_TMO], 1u); break; } } } } while (0)

struct XcdBarrier {
    unsigned* bar; unsigned x;
    volatile LAS unsigned* st;
};

__device__ __forceinline__ XcdBarrier xcd_barrier_post(unsigned* bar, volatile LAS unsigned* st) {
    XcdBarrier b; b.bar = bar; b.x = xb_xcc_id(); b.st = st;
    if (threadIdx.x == 0) (void)xb_add(&bar[XB_XCNT(b.x)], 1u);
    return b;
}
__device__ __forceinline__ void xcd_barrier_complete(unsigned* bar, unsigned x, unsigned& nloc, unsigned& nx) {
    const unsigned G = gridDim.x * gridDim.y * gridDim.z;
    unsigned sum, cnt, mine, sp = 0u;
    for (;;) {
        sum = 0u; cnt = 0u; mine = 0u;
#pragma unroll
        for (unsigned j = 0; j < 16; ++j) { const unsigned c = xb_ld(&bar[XB_XCNT(j)]); sum += c; cnt += (c > 0u) ? 1u : 0u; mine = (j == x) ? c : mine; }
        if (sum == G) break;
        __builtin_amdgcn_s_sleep(1);
        if ((++sp & 255u) == 0u) { if (xb_ld(&bar[XB_TMO])) break; if (sp > XB_SPIN_CAP) { atomicAdd(&bar[XB_TMO], 1u); break; } }
    }
    nloc = mine > 0u ? mine : 1u; nx = cnt > 0u ? cnt : 1u;
}

__device__ __forceinline__ void xcd_barrier(const XcdBarrier& b) {
    asm volatile("s_waitcnt vmcnt(0)" ::: "memory");
    __syncthreads();
    if (threadIdx.x == 0) {
        unsigned* bar = b.bar;
        __builtin_amdgcn_s_waitcnt(0);
        unsigned nloc = b.st[0], nx = b.st[1];
        if (nloc == 0u) { xcd_barrier_complete(bar, b.x, nloc, nx); b.st[0] = nloc; b.st[1] = nx; }
        const unsigned old = xb_add(&bar[XB_XSUB(b.x)], 1u);
        const unsigned gen = old / nloc;
        if (old + 1u == (gen + 1u) * nloc) {
            __builtin_amdgcn_fence(__ATOMIC_RELEASE, "agent");
            asm volatile("s_waitcnt vmcnt(0)" ::: "memory");
            const unsigned og = xb_add(&bar[XB_TOP], 1u);
            const unsigned tg = og / nx;
            if (og + 1u == (tg + 1u) * nx) xb_add(&bar[XB_TOPGEN], 1u);
            else XB_SPIN(xb_ld(&bar[XB_TOPGEN]) == tg, bar);
            __builtin_amdgcn_fence(__ATOMIC_ACQUIRE, "agent");
            xb_add(&bar[XB_XGEN(b.x)], 1u);
            asm volatile("s_waitcnt vmcnt(0)" ::: "memory");
        } else {
            XB_SPIN(xb_ld(&bar[XB_XGEN(b.x)]) == gen, bar);
            __builtin_amdgcn_fence(__ATOMIC_ACQUIRE, "agent");
            asm volatile("s_waitcnt vmcnt(0)" ::: "memory");
        }
    }
    __syncthreads();
}

constexpr int NB = 8, SEQ = 8192, T = NB * SEQ, D = 1024, DEPTH = 4;
constexpr int ZE = 2816, ZO = 3072;
constexpr int NEXP = 32, PMAX = 2 * T + NEXP * 256;
constexpr float NORM_EPS = 1e-6f;
constexpr float LOG2E = 1.4426950408889634f, LN2 = 0.6931471805599453f;
constexpr int NWAVES = 8, NTHR = 512;

constexpr size_t MiB = 1u << 20;
constexpr size_t WS_CTL = 0, CTL_ZERO_BYTES = 1 * MiB;
constexpr size_t WS_MOD = 1 * MiB;
constexpr size_t WS_TOKE = 2 * MiB;
constexpr size_t WS_TOKR = WS_TOKE + 512 * 1024;
constexpr size_t WS_TOKW = WS_TOKR + 512 * 1024;
constexpr size_t WS_TOKD = WS_TOKW + 512 * 1024;
constexpr size_t WS_DEC = 6 * MiB;
constexpr size_t WS_LSE = 7 * MiB;
constexpr size_t WS_CS = 19 * MiB;
constexpr size_t WS_WRT = 23 * MiB;
constexpr size_t WS_WIN = 24 * MiB;
constexpr size_t WS_WOE = 35 * MiB;
constexpr size_t WS_WQKV = 39 * MiB;
constexpr size_t WS_WOO = 51 * MiB;
constexpr size_t WS_W13 = 56 * MiB;
constexpr size_t WS_W2 = 120 * MiB;
constexpr size_t WS_H = 152 * MiB;
constexpr size_t WS_M = 280 * MiB;
constexpr size_t WS_X1 = 408 * MiB;
constexpr size_t WS_Z = 536 * MiB;
constexpr size_t WS_HID = WS_Z + (size_t)PMAX * 1024 * 2;
constexpr size_t WS_END = WS_HID + (size_t)PMAX * 512 * 2;
static_assert(WS_Z + (size_t)T * ZO * 2 <= WS_END && WS_END <= 1000 * MiB, "d_ws map");
constexpr int CW_CNT = 64;
constexpr int CW_BAR = 4096;

constexpr int LDS_BYTES = 152 * 1024;
constexpr int LDS_TAB = 148 * 1024;
constexpr int LDS_MISC = 150 * 1024;
constexpr int LDS_PHASE_MAX = 148 * 1024;

typedef short s16x4 __attribute__((ext_vector_type(4)));
typedef float f32x2 __attribute__((ext_vector_type(2)));
typedef unsigned v2u __attribute__((ext_vector_type(2)));
struct Frame {
    LAS unsigned char* lds;
    gu32* ctl;
    int tid, lane, wave, vcu, G;
    float* out; unsigned char* ws;
};
__device__ __forceinline__ const void* inptr_raw(int k) {
    const void* p; const void* tab = (const void*)__builtin_amdgcn_kernarg_segment_ptr();
    asm volatile("s_load_dwordx2 %0, %1, %2\n\ts_waitcnt lgkmcnt(0)" : "=s"(p) : "s"(tab), "i"(k * 8) : "memory");
    return p;
}
#define INF(k) ((const float*)inptr_raw(k))
enum { I_X = 0, I_C = 1, I_POS = 2, I_ADAW = 3, I_ADAB = 4, I_N1G = 5, I_N2G = 6, I_EWIN = 7, I_EWG2 = 8, I_EBG = 9, I_EGNG = 10, I_ECW = 11, I_ECB = 12, I_ELNG = 13, I_ELNB = 14,
       I_EWOUT = 15, I_OWQKV = 16, I_OWOUT = 17, I_MWGRP = 18, I_MBGRP = 19, I_MWRT = 20, I_MBRT = 21, I_MW1 = 22, I_MW3 = 23, I_MW2 = 24, I_FNG = 25 };

__device__ __forceinline__ float bf2f(unsigned h) { return __builtin_bit_cast(float, h << 16); }
__device__ __forceinline__ float bflo(unsigned w) { return __builtin_bit_cast(float, w << 16); }
__device__ __forceinline__ float bfhi(unsigned w) { return __builtin_bit_cast(float, w & 0xffff0000u); }
__device__ __forceinline__ float fexp(float x) { return __builtin_amdgcn_exp2f(x * LOG2E); }
__device__ __forceinline__ float frcp(float x) { return __builtin_amdgcn_rcpf(x); }
__device__ __forceinline__ float fsilu(float x) { return x * frcp(1.0f + fexp(-x)); }
__device__ __forceinline__ float fsigmoid(float x) { return frcp(1.0f + fexp(-x)); }
__device__ __forceinline__ float flogsigmoid(float x) { return fminf(x, 0.f) - __builtin_amdgcn_logf(1.0f + fexp(-fabsf(x))) * LN2; }
__device__ __forceinline__ float wave_sum(float v) {
#pragma unroll
    for (int o = 1; o < 64; o <<= 1) v += __shfl_xor(v, o);
    return v;
}

__device__ __forceinline__ void transpose_item(const float* W, int ldw, int coff, int K, bf16* WT, int mode, int row_off, LAS float* scr, int kb, int nb, int lane) {
    const int k0 = 64 * kb, n0 = 32 * nb;
#pragma unroll 8
    for (int i = 0; i < 32; ++i) { const int kk = 2 * i + (lane >> 5); scr[kk * 33 + (lane & 31)] = W[(size_t)(k0 + kk) * ldw + coff + n0 + (lane & 31)]; }
    LDS_WAIT(); asm volatile("" ::: "memory");
    const int c = lane & 7;
#pragma unroll
    for (int j = 0; j < 4; ++j) { const int n = (lane >> 3) + 8 * j; const LAS float* s = scr + (8 * c) * 33 + n;
        v4u o; o.x = pk2(s[0 * 33], s[1 * 33]); o.y = pk2(s[2 * 33], s[3 * 33]); o.z = pk2(s[4 * 33], s[5 * 33]); o.w = pk2(s[6 * 33], s[7 * 33]);
        const int nn = n0 + n; const int drow = (mode == 0) ? (row_off + nn) : (((nn >> 7) << 8) + (nn & 127) + (mode == 2 ? 128 : 0));
        *(v4u*)(WT + (size_t)drow * K + k0 + 8 * c) = o; }
    LDS_WAIT(); asm volatile("" ::: "memory");
}

__device__ __forceinline__ void convert_moe(Frame& F, int layer) {
    LAS float* scr = (LAS float*)(F.lds + F.wave * 16384);
    const int gw = blockIdx.x * NWAVES + F.wave, NGW = F.G * NWAVES;
    bf16* W13 = (bf16*)(F.ws + WS_W13); bf16* W2 = (bf16*)(F.ws + WS_W2);
    const float* m_w1 = INF(I_MW1); const float* m_w3 = INF(I_MW3); const float* m_w2 = INF(I_MW2);
    for (int it = gw; it < NEXP * 768; it += NGW) {
        const int e = it / 768, r = it % 768, which = r >> 8, q = r & 255;
        const size_t eoff = (size_t)(layer * NEXP + e) * (1024 * 512);
        if (which == 0)      transpose_item(m_w1 + eoff, 512, 0, 1024, W13 + (size_t)e * 1024 * 1024, 1, 0, scr, q >> 4, q & 15, F.lane);
        else if (which == 1) transpose_item(m_w3 + eoff, 512, 0, 1024, W13 + (size_t)e * 1024 * 1024, 2, 0, scr, q >> 4, q & 15, F.lane);
        else                 transpose_item(m_w2 + eoff, 1024, 0, 512, W2 + (size_t)e * 1024 * 512, 0, 0, scr, q >> 5, q & 31, F.lane);
    }
}

__device__ __forceinline__ void phase_prologue(Frame& F) {
    LAS float* scr = (LAS float*)(F.lds + F.wave * 16384);
    const int gw = blockIdx.x * NWAVES + F.wave, NGW = F.G * NWAVES;
    const int gt = blockIdx.x * NTHR + F.tid, NGT = F.G * NTHR;
    const float* e_win = INF(I_EWIN);
    {
        const float* e_wout = INF(I_EWOUT); const float* o_wqkv = INF(I_OWQKV); const float* o_wout = INF(I_OWOUT); const float* e_wg2 = INF(I_EWG2);
        bf16* WIN = (bf16*)(F.ws + WS_WIN); bf16* WOE = (bf16*)(F.ws + WS_WOE); bf16* WQKV = (bf16*)(F.ws + WS_WQKV); bf16* WOO = (bf16*)(F.ws + WS_WOO);
        constexpr int I_A = 16 * 48, I_U = 16 * 32, I_O = 16 * 32, I_Q = 16 * 96, PER = I_A + I_U + I_O + I_Q + I_O;
        for (int it = gw; it < 2 * PER; it += NGW) {
            const int i = it / PER; int r = it % PER;
            if (r < I_A) { transpose_item(e_win + (size_t)i * 1024 * 2576, 2576, 0, 1024, WIN + (size_t)i * ZE * 1024, 0, 0, scr, r / 48, r % 48, F.lane); continue; } r -= I_A;
            if (r < I_U) { transpose_item(e_win + (size_t)i * 1024 * 2576, 2576, 1552, 1024, WIN + (size_t)i * ZE * 1024, 0, 1792, scr, r / 32, r % 32, F.lane); continue; } r -= I_U;
            if (r < I_O) { transpose_item(e_wout + (size_t)i * 1024 * 1024, 1024, 0, 1024, WOE + (size_t)i * 1024 * 1024, 0, 0, scr, r / 32, r % 32, F.lane); continue; } r -= I_O;
            if (r < I_Q) { transpose_item(o_wqkv + (size_t)i * 1024 * 3072, 3072, 0, 1024, WQKV + (size_t)i * 3072 * 1024, 0, 0, scr, r / 96, r % 96, F.lane); continue; } r -= I_Q;
            transpose_item(o_wout + (size_t)i * 1024 * 1024, 1024, 0, 1024, WOO + (size_t)i * 1024 * 1024, 0, 0, scr, r / 32, r % 32, F.lane);
        }
        for (int it = gt; it < 2 * 256 * 128; it += NGT) {
            const int i = it >> 15, c = (it >> 7) & 255, kg = it & 127;
            const float* win = e_win + (size_t)i * 1024 * 2576 + 1536; const float* wg = e_wg2 + (size_t)i * 16 * 256 + c;
            float g[16];
#pragma unroll
            for (int r = 0; r < 16; ++r) g[r] = wg[r * 256];
            float o[8];
#pragma unroll
            for (int kk = 0; kk < 8; ++kk) { const float* wr = win + (size_t)(kg * 8 + kk) * 2576; float s = 0.f;
#pragma unroll
                for (int r = 0; r < 16; ++r) s += wr[r] * g[r];
                o[kk] = s; }
            v4u w; w.x = pk2(o[0], o[1]); w.y = pk2(o[2], o[3]); w.z = pk2(o[4], o[5]); w.w = pk2(o[6], o[7]);
            *(v4u*)(WIN + (size_t)i * ZE * 1024 + (size_t)(1536 + c) * 1024 + kg * 8) = w;
        }
    }
    {
        float* WRT = (float*)(F.ws + WS_WRT); const float* m_wgrp = INF(I_MWGRP); const float* m_wrt = INF(I_MWRT);
        for (int it = gt; it < DEPTH * 36 * 1024; it += NGT) {
            const int l = it / (36 * 1024), r = it % (36 * 1024), o = r >> 10, k = r & 1023;
            WRT[it] = (o < 4) ? m_wgrp[((size_t)l * 1024 + k) * 4 + o] : m_wrt[((size_t)l * 1024 + k) * 32 + (o - 4)];
        }
    }
    {
        float* CS = (float*)(F.ws + WS_CS); const int* pos = (const int*)inptr_raw(I_POS);
        for (int it = gt; it < T * 8; it += NGT) {
            const int t = it >> 3, i = it & 7;
            const double revs[8] = {0.15915494309189535, 0.03086376340470123, 0.005985185712713705, 0.001160663641240061, 0.00022507907903927653, 4.364795279280289e-05, 8.464330808241401e-06, 1.6414262627950345e-06};
            double rv = 0.0;
#pragma unroll
            for (int q = 0; q < 8; ++q) rv = (i == q) ? revs[q] : rv;
            const double a = (double)pos[t] * rv; const float fr = (float)(a - __builtin_rint(a));
            CS[(size_t)t * 16 + i] = __builtin_amdgcn_cosf(fr); CS[(size_t)t * 16 + 8 + i] = __builtin_amdgcn_sinf(fr);
        }
    }
    {
        float* MOD = (float*)(F.ws + WS_MOD); const float* cin = INF(I_C); const float* ada_w = INF(I_ADAW); const float* ada_b = INF(I_ADAB);
        LAS float* cond = (LAS float*)(F.lds + 0);
        LAS float* red = (LAS float*)(F.lds + 32768);
        __syncthreads();
        for (int i = F.tid; i < NB * 1024; i += NTHR) { const float v = cin[i]; cond[i] = v / (1.0f + expf(-v)); }
        __syncthreads();
        for (int it = blockIdx.x; it < DEPTH * 48; it += F.G) {
            const int l = it / 48, j0 = (it % 48) * 128;
            const float* W = ada_w + (size_t)l * 1024 * 6144 + j0 + 2 * F.lane;
            float a0[8], a1[8];
#pragma unroll
            for (int b = 0; b < 8; ++b) { a0[b] = 0.f; a1[b] = 0.f; }
            for (int k = F.wave * 128; k < F.wave * 128 + 128; ++k) {
                const f32x2 w = *(const f32x2*)(W + (size_t)k * 6144);
#pragma unroll
                for (int b = 0; b < 8; ++b) { const float cv = cond[b * 1024 + k]; a0[b] += cv * w.x; a1[b] += cv * w.y; }
            }
#pragma unroll
            for (int b = 0; b < 8; ++b) { red[(F.wave * 8 + b) * 128 + 2 * F.lane] = a0[b]; red[(F.wave * 8 + b) * 128 + 2 * F.lane + 1] = a1[b]; }
            __syncthreads();
            for (int o = F.tid; o < 8 * 128; o += NTHR) { const int b = o >> 7, j = o & 127; float s = 0.f;
#pragma unroll
                for (int w = 0; w < 8; ++w) s += red[(w * 8 + b) * 128 + j];
                MOD[((size_t)l * 8 + b) * 6144 + j0 + j] = s + ada_b[l * 6144 + j0 + j]; }
            __syncthreads();
        }
    }
}

__device__ __forceinline__ void phase_n1(Frame& F, int layer) {
    const int gw = blockIdx.x * NWAVES + F.wave; const int b = gw >> 8; const int lane = F.lane;
    const float* MOD = (const float*)(F.ws + WS_MOD);
    const bool fin = (layer == DEPTH);
    const float* fng = INF(I_FNG); const float* n1g = INF(I_N1G); const float* xin0 = INF(I_X);
    f32x4 A[4], Bv[4], G2[4];
#pragma unroll
    for (int j = 0; j < 4; ++j) { const int c = 256 * j + 4 * lane;
        if (fin) { A[j] = *(const f32x4*)(fng + c); Bv[j] = (f32x4){0.f, 0.f, 0.f, 0.f}; }
        else { const float* m = MOD + ((size_t)layer * 8 + b) * 6144; const f32x4 g = *(const f32x4*)(n1g + layer * 1024 + c), sc = *(const f32x4*)(m + 1024 + c);
            A[j] = g * (sc + 1.0f); Bv[j] = *(const f32x4*)(m + c); }
        G2[j] = (f32x4){0.f, 0.f, 0.f, 0.f};
        if (layer > 0) G2[j] = *(const f32x4*)(MOD + ((size_t)(layer - 1) * 8 + b) * 6144 + 5120 + c); }
    const int* TD = (const int*)(F.ws + WS_TOKD); const float* TW = (const float*)(F.ws + WS_TOKW);
    const bf16* YS = (const bf16*)(F.ws + WS_Z); bf16* H = (bf16*)(F.ws + WS_H);
    for (int r = 0; r < 32; ++r) {
        const size_t t = (size_t)gw * 32 + r;
        f32x4 v[4];
        if (layer == 0) {
#pragma unroll
            for (int j = 0; j < 4; ++j) v[j] = *(const f32x4*)(xin0 + t * D + 256 * j + 4 * lane);
        } else {
            const int d0 = TD[2 * t], d1 = TD[2 * t + 1]; const float w0 = TW[2 * t], w1 = TW[2 * t + 1];
#pragma unroll
            for (int j = 0; j < 4; ++j) { const int c = 256 * j + 4 * lane;
                const f32x4 xv = *(const f32x4*)(F.out + t * D + c);
                const v2u y0 = *(const v2u*)(YS + (size_t)d0 * D + c), y1 = *(const v2u*)(YS + (size_t)d1 * D + c);
                f32x4 y; y.x = w0 * bflo(y0.x) + w1 * bflo(y1.x); y.y = w0 * bfhi(y0.x) + w1 * bfhi(y1.x); y.z = w0 * bflo(y0.y) + w1 * bflo(y1.y); y.w = w0 * bfhi(y0.y) + w1 * bfhi(y1.y);
                v[j] = xv + G2[j] * y; }
            if (!fin) {
#pragma unroll
                for (int j = 0; j < 4; ++j) *(f32x4*)(F.out + t * D + 256 * j + 4 * lane) = v[j];
            }
        }
        float ss = 0.f;
#pragma unroll
        for (int j = 0; j < 4; ++j) ss += (v[j].x * v[j].x + v[j].y * v[j].y) + (v[j].z * v[j].z + v[j].w * v[j].w);
        const float rstd = __builtin_amdgcn_rsqf(wave_sum(ss) * (1.0f / D) + NORM_EPS);
        if (fin) {
#pragma unroll
            for (int j = 0; j < 4; ++j) *(f32x4*)(F.out + t * D + 256 * j + 4 * lane) = v[j] * rstd * A[j];
        } else {
#pragma unroll
            for (int j = 0; j < 4; ++j) { const f32x4 h = v[j] * rstd * A[j] + Bv[j]; v2u o; o.x = pk2(h.x, h.y); o.y = pk2(h.z, h.w);
                *(v2u*)(H + t * D + 256 * j + 4 * lane) = o; }
        }
    }
}

__device__ __forceinline__ void phase_n2(Frame& F, int layer) {
    const int gw = blockIdx.x * NWAVES + F.wave; const int b = gw >> 8; const int lane = F.lane;
    const float* MOD = (const float*)(F.ws + WS_MOD) + ((size_t)layer * 8 + b) * 6144;
    LAS float* lg = (LAS float*)(F.lds + 0);
    LAS int* le = (LAS int*)(F.lds + 8192);
    LAS int* lr = (LAS int*)(F.lds + 8192 + 2048);
    LAS int* lcnt = (LAS int*)(F.lds + 8192 + 4096);
    LAS int* lbase = (LAS int*)(F.lds + 8192 + 4096 + 128);
    __syncthreads();
    if (F.tid < 32) lcnt[F.tid] = 0;
    __syncthreads();
    const float* n2g = INF(I_N2G); const float* m_bgrp = INF(I_MBGRP); const float* m_brt = INF(I_MBRT);
    f32x4 A[4], Bv[4], G1[4];
#pragma unroll
    for (int j = 0; j < 4; ++j) { const int c = 256 * j + 4 * lane;
        const f32x4 g = *(const f32x4*)(n2g + layer * 1024 + c), sc = *(const f32x4*)(MOD + 4096 + c);
        A[j] = g * (sc + 1.0f); Bv[j] = *(const f32x4*)(MOD + 3072 + c); G1[j] = *(const f32x4*)(MOD + 2048 + c); }
    const float* xin = (layer == 0) ? INF(I_X) : F.out;
    const bf16* Y = (const bf16*)(F.ws + WS_Z); bf16* H = (bf16*)(F.ws + WS_H);
    const float* WRT = (const float*)(F.ws + WS_WRT) + (size_t)layer * 36 * 1024;
    float* TW = (float*)(F.ws + WS_TOKW);
    for (int rg = 0; rg < 8; ++rg) {
        f32x4 h[4][4];
#pragma unroll
        for (int q = 0; q < 4; ++q) {
            const size_t t = (size_t)gw * 32 + rg * 4 + q;
            float ss = 0.f;
#pragma unroll
            for (int j = 0; j < 4; ++j) { const int c = 256 * j + 4 * lane;
                const f32x4 xv = *(const f32x4*)(xin + t * D + c); const v2u yv = *(const v2u*)(Y + t * D + c);
                f32x4 y; y.x = bflo(yv.x); y.y = bfhi(yv.x); y.z = bflo(yv.y); y.w = bfhi(yv.y);
                const f32x4 v = xv + G1[j] * y; h[q][j] = v;
                *(f32x4*)(F.out + t * D + c) = v;
                ss += (v.x * v.x + v.y * v.y) + (v.z * v.z + v.w * v.w); }
            const float rstd = __builtin_amdgcn_rsqf(wave_sum(ss) * (1.0f / D) + NORM_EPS);
#pragma unroll
            for (int j = 0; j < 4; ++j) { const f32x4 hv = h[q][j] * rstd * A[j] + Bv[j]; h[q][j] = hv; v2u o; o.x = pk2(hv.x, hv.y); o.y = pk2(hv.z, hv.w);
                *(v2u*)(H + t * D + 256 * j + 4 * lane) = o; }
        }
        for (int o = 0; o < 36; ++o) {
            f32x4 w[4];
#pragma unroll
            for (int j = 0; j < 4; ++j) w[j] = *(const f32x4*)(WRT + o * 1024 + 256 * j + 4 * lane);
#pragma unroll
            for (int q = 0; q < 4; ++q) { float p = 0.f;
#pragma unroll
                for (int j = 0; j < 4; ++j) p += (h[q][j].x * w[j].x + h[q][j].y * w[j].y) + (h[q][j].z * w[j].z + h[q][j].w * w[j].w);
                p = wave_sum(p);
                if (lane == 0) lg[(F.wave * 4 + q) * 36 + o] = p; }
        }
        LDS_WAIT(); asm volatile("" ::: "memory");
        if (lane < 4) {
            const LAS float* L = lg + (F.wave * 4 + lane) * 36;
            const float* bg = m_bgrp + layer * 4; const float* br = m_brt + layer * 32;
            float gl[4];
#pragma unroll
            for (int i = 0; i < 4; ++i) gl[i] = L[i] + bg[i];
            int gi = 0; float gm = gl[0];
#pragma unroll
            for (int i = 1; i < 4; ++i) if (gl[i] > gm) { gm = gl[i]; gi = i; }
            float gs = 0.f;
#pragma unroll
            for (int i = 0; i < 4; ++i) gs += expf(gl[i] - gm);
            const float gwt = 1.0f / gs;
            float ev[8];
#pragma unroll
            for (int i = 0; i < 8; ++i) ev[i] = L[4 + gi * 8 + i] + br[gi * 8 + i];
            int i1 = 0; float v1 = ev[0];
#pragma unroll
            for (int i = 1; i < 8; ++i) if (ev[i] > v1) { v1 = ev[i]; i1 = i; }
            int i2 = -1; float v2 = -3.0e38f;
#pragma unroll
            for (int i = 0; i < 8; ++i) if (i != i1 && ev[i] > v2) { v2 = ev[i]; i2 = i; }
            const float ex = expf(v2 - v1); const float w1 = 1.0f / (1.0f + ex), w2 = ex * w1;
            const int e0 = gi * 8 + i1, e1 = gi * 8 + i2;
            const int lrow = F.wave * 32 + rg * 4 + lane;
            le[2 * lrow] = e0; le[2 * lrow + 1] = e1;
            lr[2 * lrow] = __hip_atomic_fetch_add(&lcnt[e0], 1, __ATOMIC_RELAXED, __HIP_MEMORY_SCOPE_WORKGROUP); lr[2 * lrow + 1] = __hip_atomic_fetch_add(&lcnt[e1], 1, __ATOMIC_RELAXED, __HIP_MEMORY_SCOPE_WORKGROUP);
            const size_t t = (size_t)gw * 32 + rg * 4 + lane;
            TW[2 * t] = w1 * gwt; TW[2 * t + 1] = w2 * gwt;
        }
        LDS_WAIT(); asm volatile("" ::: "memory");
    }
    __syncthreads();
    if (F.tid < 32) lbase[F.tid] = (int)atomicAdd((unsigned*)(F.ctl + CW_CNT + layer * 32 + F.tid), (unsigned)lcnt[F.tid]);
    __syncthreads();
    {
        int* TE = (int*)(F.ws + WS_TOKE); int* TR = (int*)(F.ws + WS_TOKR);
        const int a = F.tid;
        const int lrow = a >> 1; const size_t t = (size_t)(blockIdx.x * NWAVES + (lrow >> 5)) * 32 + (lrow & 31);
        const int e = le[a];
        TE[2 * t + (a & 1)] = e; TR[2 * t + (a & 1)] = lbase[e] + lr[a];
    }
}

__device__ __forceinline__ void build_tstart(Frame& F, int layer) {
    LAS int* ts = (LAS int*)(F.lds + LDS_TAB);
    __syncthreads();
    if (F.tid == 0) { int acc = 0;
        for (int e = 0; e < NEXP; ++e) { ts[e] = acc; const unsigned cn = __hip_atomic_load(F.ctl + CW_CNT + layer * 32 + e, RLX_AGENT); acc += (int)((cn + 255u) >> 8); }
        ts[NEXP] = acc; }
    __syncthreads();
}

__device__ __forceinline__ void phase_route(Frame& F, int layer) {
    build_tstart(F, layer);
    const LAS int* ts = (const LAS int*)(F.lds + LDS_TAB);
    const int gw = blockIdx.x * NWAVES + F.wave; const int lane = F.lane;
    const int* TE = (const int*)(F.ws + WS_TOKE); const int* TR = (const int*)(F.ws + WS_TOKR); int* TD = (int*)(F.ws + WS_TOKD);
    const bf16* H = (const bf16*)(F.ws + WS_H); bf16* XS = (bf16*)(F.ws + WS_Z);
    for (int r = 0; r < 32; ++r) {
        const size_t t = (size_t)gw * 32 + r;
        const int d0 = ts[TE[2 * t]] * 256 + TR[2 * t], d1 = ts[TE[2 * t + 1]] * 256 + TR[2 * t + 1];
        if (lane == 0) { TD[2 * t] = d0; TD[2 * t + 1] = d1; }
        const v4u a = *(const v4u*)(H + t * D + 8 * lane), c = *(const v4u*)(H + t * D + 512 + 8 * lane);
        *(v4u*)(XS + (size_t)d0 * D + 8 * lane) = a; *(v4u*)(XS + (size_t)d0 * D + 512 + 8 * lane) = c;
        *(v4u*)(XS + (size_t)d1 * D + 8 * lane) = a; *(v4u*)(XS + (size_t)d1 * D + 512 + 8 * lane) = c;
    }
}

__device__ __forceinline__ void gla_load_chunk(Frame& F, const bf16* Z, int i, size_t t0, int h, LAS float* qq, LAS float* kk, LAS float* bb, LAS float* vv, bool want_q) {
    const float* bgate = INF(I_EBG) + i * 256 + h * 64;
    for (int id = F.tid; id < 64 * 64; id += NTHR) { const int j = id >> 6, c = id & 63; const bf16* zr = Z + (t0 + j) * ZE;
        kk[j * 65 + c] = bf2f(zr[256 + h * 64 + c]);
        bb[j * 65 + c] = flogsigmoid(bf2f(zr[1536 + h * 64 + c]) + bgate[c]) * (1.0f / 16.0f);
        if (want_q) qq[j * 65 + c] = bf2f(zr[h * 64 + c]) * 0.125f; }
    for (int id = F.tid; id < 64 * 128; id += NTHR) { const int j = id >> 7, c = id & 127; vv[j * 128 + c] = bf2f(Z[(t0 + j) * ZE + 512 + h * 128 + c]); }
    __syncthreads();
    if (F.tid < 64) { float s = 0.f; for (int j = 0; j < 64; ++j) { s += bb[j * 65 + F.tid]; bb[j * 65 + F.tid] = s; } }
    __syncthreads();
}
__device__ __forceinline__ void phase_gla_kv(Frame& F, int i) {
    const bf16* Z = (const bf16*)(F.ws + WS_Z); float* KV = (float*)(F.ws + WS_H); float* DEC = (float*)(F.ws + WS_DEC);
    LAS float* kk = (LAS float*)(F.lds + 0); LAS float* bb = (LAS float*)(F.lds + 16640); LAS float* vv = (LAS float*)(F.lds + 33280);
    for (int u = blockIdx.x; u < 32 * 128; u += F.G) {
        const int bh = u >> 7, n = u & 127, b = bh >> 2, h = bh & 3; const size_t t0 = (size_t)b * SEQ + n * 64;
        __syncthreads();
        gla_load_chunk(F, Z, i, t0, h, kk, kk, bb, vv, false);
        for (int id = F.tid; id < 64 * 64; id += NTHR) { const int j = id >> 6, c = id & 63; kk[j * 65 + c] *= fexp(bb[63 * 65 + c] - bb[j * 65 + c]); }
        if (F.tid < 64) DEC[(size_t)u * 64 + F.tid] = fexp(bb[63 * 65 + F.tid]);
        __syncthreads();
        const int c4 = F.tid >> 5, v4 = F.tid & 31;
        f32x4 acc[4];
#pragma unroll
        for (int ii = 0; ii < 4; ++ii) acc[ii] = (f32x4){0.f, 0.f, 0.f, 0.f};
        for (int j = 0; j < 64; ++j) { const f32x4 bv = *(const LAS f32x4*)(vv + j * 128 + 4 * v4);
#pragma unroll
            for (int ii = 0; ii < 4; ++ii) acc[ii] += bv * kk[j * 65 + 4 * c4 + ii]; }
#pragma unroll
        for (int ii = 0; ii < 4; ++ii) *(f32x4*)(KV + ((size_t)u * 64 + 4 * c4 + ii) * 128 + 4 * v4) = acc[ii];
    }
}
__device__ __forceinline__ void phase_gla_scan(Frame& F) {
    float* KV = (float*)(F.ws + WS_H); const float* DEC = (const float*)(F.ws + WS_DEC);
    for (int gt = blockIdx.x * NTHR + F.tid; gt < 32 * 4096; gt += F.G * NTHR) {
        const int bh = gt >> 12, e2 = gt & 4095, k = e2 >> 6;
        float* p = KV + (size_t)bh * 128 * 8192 + 2 * e2; const float* dp = DEC + (size_t)bh * 128 * 64 + k;
        f32x2 st = {0.f, 0.f};
#pragma unroll 8
        for (int n = 0; n < 128; ++n) { const f32x2 kv = *(const f32x2*)(p + (size_t)n * 8192); const float d = dp[n * 64];
            *(f32x2*)(p + (size_t)n * 8192) = st; st = st * d + kv; }
    }
}
__device__ __forceinline__ void phase_gla_out(Frame& F, int i) {
    const bf16* Z = (const bf16*)(F.ws + WS_Z); const float* KV = (const float*)(F.ws + WS_H); bf16* MIX = (bf16*)(F.ws + WS_M);
    LAS float* qq = (LAS float*)(F.lds + 0); LAS float* kk = (LAS float*)(F.lds + 16640); LAS float* bb = (LAS float*)(F.lds + 33280);
    LAS float* vv = (LAS float*)(F.lds + 49920); LAS float* st = (LAS float*)(F.lds + 49920 + 32768);
    LAS float* att = bb;
    const float* gng = INF(I_EGNG) + i * 128;
    for (int u = blockIdx.x; u < 32 * 128; u += F.G) {
        const int bh = u >> 7, n = u & 127, b = bh >> 2, h = bh & 3; const size_t t0 = (size_t)b * SEQ + n * 64;
        __syncthreads();
        for (int id = F.tid; id < 64 * 32; id += NTHR) *(LAS f32x4*)(st + 4 * id) = *(const f32x4*)(KV + (size_t)u * 8192 + 4 * id);
        gla_load_chunk(F, Z, i, t0, h, qq, kk, bb, vv, true);
        for (int id = F.tid; id < 64 * 64; id += NTHR) { const int j = id >> 6, c = id & 63; const float bv = bb[j * 65 + c];
            qq[j * 65 + c] *= fexp(bv); kk[j * 65 + c] *= fexp(-bv); }
        __syncthreads();
        {
            const int i4 = F.tid >> 5, jj = F.tid & 31;
            float a0[4], a1[4];
#pragma unroll
            for (int ii = 0; ii < 4; ++ii) { a0[ii] = 0.f; a1[ii] = 0.f; }
            for (int c = 0; c < 64; ++c) { const float k0 = kk[jj * 65 + c], k1 = kk[(jj + 32) * 65 + c];
#pragma unroll
                for (int ii = 0; ii < 4; ++ii) { const float qv = qq[(4 * i4 + ii) * 65 + c]; a0[ii] += qv * k0; a1[ii] += qv * k1; } }
            __syncthreads();
#pragma unroll
            for (int ii = 0; ii < 4; ++ii) { const int r = 4 * i4 + ii; att[r * 65 + jj] = (r >= jj) ? a0[ii] : 0.f; att[r * 65 + jj + 32] = (r >= jj + 32) ? a1[ii] : 0.f; }
        }
        __syncthreads();
        {
            const int i4 = F.tid >> 5, v4 = F.tid & 31;
            f32x4 acc[4];
#pragma unroll
            for (int ii = 0; ii < 4; ++ii) acc[ii] = (f32x4){0.f, 0.f, 0.f, 0.f};
            for (int j = 0; j < 64; ++j) { const f32x4 bv = *(const LAS f32x4*)(vv + j * 128 + 4 * v4), sv = *(const LAS f32x4*)(st + j * 128 + 4 * v4);
#pragma unroll
                for (int ii = 0; ii < 4; ++ii) acc[ii] += bv * att[(4 * i4 + ii) * 65 + j] + sv * qq[(4 * i4 + ii) * 65 + j]; }
            const f32x4 gn = *(const f32x4*)(gng + 4 * v4);
#pragma unroll
            for (int ii = 0; ii < 4; ++ii) {
                float ss = (acc[ii].x * acc[ii].x + acc[ii].y * acc[ii].y) + (acc[ii].z * acc[ii].z + acc[ii].w * acc[ii].w);
#pragma unroll
                for (int o = 1; o < 32; o <<= 1) ss += __shfl_xor(ss, o);
                const float rstd = __builtin_amdgcn_rsqf(ss * (1.0f / 128.0f) + NORM_EPS);
                const size_t t = t0 + 4 * i4 + ii;
                const v2u gv = *(const v2u*)(Z + t * ZE + 1024 + h * 128 + 4 * v4);
                const f32x4 o = acc[ii] * rstd * gn;
                v2u w; w.x = pk2(o.x * fsilu(bflo(gv.x)), o.y * fsilu(bfhi(gv.x))); w.y = pk2(o.z * fsilu(bflo(gv.y)), o.w * fsilu(bfhi(gv.y)));
                *(v2u*)(MIX + t * D + h * 128 + 4 * v4) = w; }
        }
    }
}
__device__ __forceinline__ void phase_conv(Frame& F, int i) {
    const bf16* Z = (const bf16*)(F.ws + WS_Z); bf16* MIX = (bf16*)(F.ws + WS_M);
    LAS float* glu = (LAS float*)(F.lds + 0);
    LAS float* red = (LAS float*)(F.lds + 62 * 512 * 4);
    const int c = F.tid;
    const float* cw = INF(I_ECW) + (size_t)i * 31 * 512 + c;
    const float cb = INF(I_ECB)[i * 512 + c], lg = INF(I_ELNG)[i * 512 + c], lb = INF(I_ELNB)[i * 512 + c];
    for (int u = blockIdx.x; u < T / 32; u += F.G) {
        const int b = u >> 8, s0 = (u & 255) * 32; const size_t t0 = (size_t)b * SEQ + s0;
        __syncthreads();
        for (int r = 0; r < 62; ++r) { const int s = s0 - 30 + r; float g = 0.f;
            if (s >= 0) { const bf16* zr = Z + ((size_t)b * SEQ + s) * ZE; g = bf2f(zr[1792 + c]) * fsigmoid(bf2f(zr[2304 + c])); }
            glu[r * 512 + c] = g; }
        __syncthreads();
        for (int hf = 0; hf < 2; ++hf) {
            float y[16];
#pragma unroll
            for (int tt = 0; tt < 16; ++tt) y[tt] = cb;
            for (int w = 0; w < 31; ++w) { const float wv = cw[w * 512];
#pragma unroll
                for (int tt = 0; tt < 16; ++tt) y[tt] += glu[(hf * 16 + tt + w) * 512 + c] * wv; }
#pragma unroll
            for (int tt = 0; tt < 16; ++tt) { const float s = wave_sum(y[tt]); if (F.lane == 0) red[F.wave * 16 + tt] = s; }
            __syncthreads();
#pragma unroll
            for (int tt = 0; tt < 16; ++tt) { float s = 0.f;
#pragma unroll
                for (int w = 0; w < 8; ++w) s += red[w * 16 + tt];
                y[tt] -= s * (1.0f / 512.0f); }
            __syncthreads();
#pragma unroll
            for (int tt = 0; tt < 16; ++tt) { const float s = wave_sum(y[tt] * y[tt]); if (F.lane == 0) red[F.wave * 16 + tt] = s; }
            __syncthreads();
#pragma unroll
            for (int tt = 0; tt < 16; ++tt) { float s = 0.f;
#pragma unroll
                for (int w = 0; w < 8; ++w) s += red[w * 16 + tt];
                const float rstd = __builtin_amdgcn_rsqf(s * (1.0f / 512.0f) + NORM_EPS);
                const float o = y[tt] * rstd * lg + lb;
                MIX[(t0 + hf * 16 + tt) * D + 512 + c] = (bf16)f2bf(fsilu(o)); }
            __syncthreads();
        }
    }
}

__device__ __forceinline__ s16x4 vtr(const LAS unsigned char* p) { return __builtin_bit_cast(s16x4, __builtin_amdgcn_ds_read_tr16_b64_v4i16((LAS v4i16_t*)p)); }
__device__ __forceinline__ void phase_attn(Frame& F) {
    const bf16* Z = (const bf16*)(F.ws + WS_Z);
    LAS unsigned char* Ks = F.lds; LAS unsigned char* Vs = F.lds + 256 * 144;
    const int tid = F.tid, lane = F.lane, w = F.wave, c = lane & 15, g = lane >> 4;
    for (int u = blockIdx.x; u < 3 * 8192; u += F.G) {
        const int br = u >> 13, rem = u & 8191, bh = rem >> 6, wi = rem & 63, b = bh >> 4, h = bh & 15;
        const int d = (br == 0) ? 1 : (br == 1 ? 4 : 16);
        const int r = wi % d, nb = wi / d;
        bf16* Obr = (bf16*)(F.ws + (br == 0 ? WS_H : (br == 1 ? WS_X1 : WS_M))); float* Lbr = (float*)(F.ws + WS_LSE) + (size_t)br * T * 16;
        __syncthreads();
#pragma unroll
        for (int i = 0; i < 4; ++i) { const int id = tid + NTHR * i, row = id >> 3, ch = id & 7; const int lk = 128 * (nb - 1) + row;
            v4u kv = {0u, 0u, 0u, 0u}, vv = {0u, 0u, 0u, 0u};
            if (lk >= 0) { const bf16* p = Z + ((size_t)b * SEQ + r + (size_t)d * lk) * ZO + h * 64 + ch * 8; kv = *(const v4u*)(p + 1024); vv = *(const v4u*)(p + 2048); }
            *(LAS v4u*)(Ks + row * 144 + ch * 16) = kv; *(LAS v4u*)(Vs + row * 144 + ch * 16) = vv; }
        const size_t tq = (size_t)b * SEQ + r + (size_t)d * (128 * nb + 16 * w + c);
        const bf16x8 q0 = *(const bf16x8*)(Z + tq * ZO + h * 64 + 8 * g), q1 = *(const bf16x8*)(Z + tq * ZO + h * 64 + 32 + 8 * g);
        __syncthreads();
        f32x4 S[9];
#pragma unroll
        for (int kt = 0; kt < 9; ++kt) { const int row = 16 * w + 16 * kt + c;
            const bf16x8 k0 = *(const LAS bf16x8*)(Ks + row * 144 + g * 16), k1 = *(const LAS bf16x8*)(Ks + row * 144 + 64 + g * 16);
            f32x4 z = {0.f, 0.f, 0.f, 0.f};
            z = __builtin_amdgcn_mfma_f32_16x16x32_bf16(k0, q0, z, 0, 0, 0); S[kt] = __builtin_amdgcn_mfma_f32_16x16x32_bf16(k1, q1, z, 0, 0, 0); }
        const int lk0 = 128 * (nb - 1) + 16 * w;
        float m = -3.0e38f;
#pragma unroll
        for (int kt = 0; kt < 9; ++kt)
#pragma unroll
            for (int i = 0; i < 4; ++i) { const int kin = 16 * kt + 4 * g + i; const int dist = c + 128 - kin;
                const bool valid = (dist >= 0) && (dist <= 128) && (lk0 + kin >= 0);
                const float s = valid ? S[kt][i] * LOG2E : -3.0e38f; S[kt][i] = s; m = fmaxf(m, s); }
        m = fmaxf(m, __shfl_xor(m, 16)); m = fmaxf(m, __shfl_xor(m, 32));
        float l = 0.f;
#pragma unroll
        for (int kt = 0; kt < 9; ++kt)
#pragma unroll
            for (int i = 0; i < 4; ++i) { const float p = __builtin_amdgcn_exp2f(S[kt][i] - m); S[kt][i] = p; l += p; }
        l += __shfl_xor(l, 16); l += __shfl_xor(l, 32);
        f32x4 O[4];
#pragma unroll
        for (int dt = 0; dt < 4; ++dt) O[dt] = (f32x4){0.f, 0.f, 0.f, 0.f};
#pragma unroll
        for (int sp = 0; sp < 5; ++sp) {
            const int kt0 = 2 * sp, kt1 = (sp < 4) ? 2 * sp + 1 : 8;
            v4u pbu; pbu.x = pk2(S[kt0][0], S[kt0][1]); pbu.y = pk2(S[kt0][2], S[kt0][3]);
            if (sp < 4) { pbu.z = pk2(S[kt1][0], S[kt1][1]); pbu.w = pk2(S[kt1][2], S[kt1][3]); } else { pbu.z = 0u; pbu.w = 0u; }
            const bf16x8 pb = __builtin_bit_cast(bf16x8, pbu);
            const int rowA = 16 * w + 16 * kt0 + 4 * g + (c >> 2), rowB = 16 * w + 16 * kt1 + 4 * g + (c >> 2);
#pragma unroll
            for (int dt = 0; dt < 4; ++dt) {
                const s16x4 lo = vtr(Vs + rowA * 144 + (16 * dt + 4 * (c & 3)) * 2), hi = vtr(Vs + rowB * 144 + (16 * dt + 4 * (c & 3)) * 2);
                const bf16x8 va = {lo[0], lo[1], lo[2], lo[3], hi[0], hi[1], hi[2], hi[3]};
                O[dt] = __builtin_amdgcn_mfma_f32_16x16x32_bf16(va, pb, O[dt], 0, 0, 0); }
        }
        const float inv = frcp(l);
#pragma unroll
        for (int dt = 0; dt < 4; ++dt) { v2u o; o.x = pk2(O[dt][0] * inv, O[dt][1] * inv); o.y = pk2(O[dt][2] * inv, O[dt][3] * inv);
            *(v2u*)(Obr + tq * D + h * 64 + 16 * dt + 4 * g) = o; }
        if (g == 0) Lbr[tq * 16 + h] = (m + __builtin_amdgcn_logf(l)) * LN2;
    }
}
__device__ __forceinline__ void phase_attn_combine(Frame& F) {
    const int gw = blockIdx.x * NWAVES + F.wave; const int lane = F.lane;
    const bf16* O1 = (const bf16*)(F.ws + WS_H); const bf16* O2 = (const bf16*)(F.ws + WS_X1); bf16* O3 = (bf16*)(F.ws + WS_M);
    const float* L = (const float*)(F.ws + WS_LSE);
    for (int r = 0; r < 32; ++r) {
        const size_t t = (size_t)gw * 32 + r;
#pragma unroll
        for (int j = 0; j < 4; ++j) { const int c = 256 * j + 4 * lane, hd = c >> 6;
            const float l1 = L[t * 16 + hd], l2 = L[(size_t)T * 16 + t * 16 + hd], l3 = L[(size_t)2 * T * 16 + t * 16 + hd];
            const float mx = fmaxf(l1, fmaxf(l2, l3)); float w1 = fexp(l1 - mx), w2 = fexp(l2 - mx), w3 = fexp(l3 - mx); const float inv = frcp(w1 + w2 + w3); w1 *= inv; w2 *= inv; w3 *= inv;
            const v2u a = *(const v2u*)(O1 + t * D + c), bq = *(const v2u*)(O2 + t * D + c), cq = *(const v2u*)(O3 + t * D + c);
            v2u o; o.x = pk2(w1 * bflo(a.x) + w2 * bflo(bq.x) + w3 * bflo(cq.x), w1 * bfhi(a.x) + w2 * bfhi(bq.x) + w3 * bfhi(cq.x));
            o.y = pk2(w1 * bflo(a.y) + w2 * bflo(bq.y) + w3 * bflo(cq.y), w1 * bfhi(a.y) + w2 * bfhi(bq.y) + w3 * bfhi(cq.y));
            *(v2u*)(O3 + t * D + c) = o; }
    }
}

constexpr int NPH = 42;
#ifndef MK_ONE_LAUNCH
#define MK_ONE_LAUNCH 0
#endif
struct Args { const void* in[26]; float* out; unsigned char* ws; int ph_lo, ph_hi; };
__global__ void __launch_bounds__(NTHR, 2) mk_fwd(Args args) {
    extern __shared__ __attribute__((aligned(16))) unsigned char lds_raw[];
    Frame F;
    F.lds = (LAS unsigned char*)lds_raw;
    F.tid = threadIdx.x; F.lane = F.tid & 63; F.wave = __builtin_amdgcn_readfirstlane(F.tid >> 6);
    F.G = gridDim.x; { const int bx = blockIdx.x; F.vcu = (F.G % 8 == 0) ? (bx % 8) * (F.G / 8) + bx / 8 : bx; }
    F.ws = args.ws; F.out = args.out; F.ctl = (gu32*)(args.ws + WS_CTL);
    volatile LAS unsigned* MISC = (volatile LAS unsigned*)(F.lds + LDS_MISC);
    if (F.tid < 64) MISC[F.tid] = 0u;
    __syncthreads();
    const int lo = args.ph_lo, hi = args.ph_hi;
    XcdBarrier bar; bar.bar = (unsigned*)(F.ctl + CW_BAR); bar.x = 0; bar.st = MISC;
    if (hi - lo > 1) bar = xcd_barrier_post((unsigned*)(F.ctl + CW_BAR), MISC);
#ifndef MK_SITES
#define MK_SITES 0xFFFF
#endif
#define SITE(n) (((MK_SITES) >> (n)) & 1)
#ifndef MK_SUB
#define MK_SUB 0xFF
#endif
#define SUB(n) (((MK_SUB) >> (n)) & 1)
#define IN(k) (lo <= (k) && (k) < hi)
#define FRESH() do { int t_ = threadIdx.x; asm volatile("" : "+v"(t_)); F.tid = t_; F.lane = t_ & 63; F.wave = __builtin_amdgcn_readfirstlane(t_ >> 6); int v_ = F.vcu; asm volatile("" : "+s"(v_)); F.vcu = v_; } while (0)
#define SEAM(k) do { if (IN(k) && IN((k) + 1)) xcd_barrier(bar); } while (0)
    bf16* const H = (bf16*)(F.ws + WS_H); bf16* const M_ = (bf16*)(F.ws + WS_M); bf16* const Z = (bf16*)(F.ws + WS_Z); bf16* const HID = (bf16*)(F.ws + WS_HID);

    if (SITE(0) && IN(0)) { FRESH(); phase_prologue(F); convert_moe(F, 0); }
    SEAM(0);
    for (int l = 0; l < DEPTH; ++l) {
        const int pb = 1 + 10 * l, i = l >> 1; const bool odd = (l & 1) != 0;
        if (SITE(1) && IN(pb + 0)) { FRESH(); if (l > 0) convert_moe(F, l); phase_n1(F, l); }
        SEAM(pb + 0);
        if (SITE(2) && IN(pb + 1)) { FRESH();
            if (SUB(0) && !odd) { pg8::Gemm g{H, (const bf16*)(F.ws + WS_WIN) + (size_t)i * ZE * 1024, T, ZE, 1024}; pg8::StaticOrder S; S.init(T, ZE, F.G, (int)blockIdx.x);
                pg8::EpiStore E{Z, ZE, ZE / 256};
                pg8::gemm_phase<pg8::EpiStore, pg8::StaticOrder, true, true>(F.lds, g, S, E); }
            else if (SUB(1)) { pg8::Gemm g{H, (const bf16*)(F.ws + WS_WQKV) + (size_t)i * ZO * 1024, T, ZO, 1024}; pg8::StaticOrder S; S.init(T, ZO, F.G, (int)blockIdx.x);
                pg8::EpiQkv E{Z, ZO, (const float*)(F.ws + WS_CS)};
                pg8::gemm_phase<pg8::EpiQkv, pg8::StaticOrder, true, true>(F.lds, g, S, E); }
        }
        SEAM(pb + 1);
        if (SITE(3) && IN(pb + 2)) { FRESH(); if (!odd) { if (SUB(2)) phase_gla_kv(F, i); if (SUB(3)) phase_conv(F, i); } else if (SUB(4)) phase_attn(F); }
        SEAM(pb + 2);
        if (SITE(4) && IN(pb + 3)) { FRESH(); if (!odd) phase_gla_scan(F); else phase_attn_combine(F); }
        SEAM(pb + 3);
        if (SITE(5) && IN(pb + 4)) { FRESH(); if (!odd) phase_gla_out(F, i); }
        SEAM(pb + 4);
        if (SITE(6) && IN(pb + 5)) { FRESH();
            pg8::Gemm g{M_, (const bf16*)(F.ws + (odd ? WS_WOO : WS_WOE)) + (size_t)i * 1024 * 1024, T, 1024, 1024}; pg8::StaticOrder S; S.init(T, 1024, F.G, (int)blockIdx.x);
            pg8::EpiStore E{Z, 1024, 4};
            pg8::gemm_phase<pg8::EpiStore, pg8::StaticOrder, true, true>(F.lds, g, S, E);
        }
        SEAM(pb + 5);
        if (SITE(7) && IN(pb + 6)) { FRESH(); phase_n2(F, l); }
        SEAM(pb + 6);
        if (SITE(8) && IN(pb + 7)) { FRESH(); phase_route(F, l); }
        SEAM(pb + 7);
        if (SITE(9) && IN(pb + 8)) { FRESH();
            build_tstart(F, l);
            pg8::Gemm g{Z, (const bf16*)(F.ws + WS_W13), PMAX, 1024, 1024}; pg8::GroupOrder S{(const LAS int*)(F.lds + LDS_TAB), F.G, F.vcu};
            pg8::EpiSwiglu E{HID};
            pg8::gemm_phase<pg8::EpiSwiglu, pg8::GroupOrder, true, true>(F.lds, g, S, E);
        }
        SEAM(pb + 8);
        if (SITE(10) && IN(pb + 9)) { FRESH();
            build_tstart(F, l);
            pg8::Gemm g{HID, (const bf16*)(F.ws + WS_W2), PMAX, 1024, 512}; pg8::GroupOrder S{(const LAS int*)(F.lds + LDS_TAB), F.G, F.vcu};
            pg8::EpiStore E{Z, 1024, 4};
            pg8::gemm_phase<pg8::EpiStore, pg8::GroupOrder, true, true>(F.lds, g, S, E);
        }
        SEAM(pb + 9);
    }
    if (SITE(11) && IN(NPH - 1)) { FRESH(); phase_n1(F, DEPTH); }
#undef IN
#undef SEAM
}

extern "C" void kernel_launch(void* const* d_in, const int* in_sizes, int n_in, void* d_out, int out_size, void* d_ws, size_t ws_size, hipStream_t stream) {
    static int grid = 0;
    if (grid == 0) {
        if (n_in != 26 || out_size != T * D || ws_size < WS_END) { fprintf(stderr, "kernel_launch: unexpected problem (n_in %d, out %d, ws %zu < %zu); nothing launched\n", n_in, out_size, ws_size, (size_t)WS_END); grid = -1; return; }
        if (hipFuncSetAttribute((const void*)mk_fwd, hipFuncAttributeMaxDynamicSharedMemorySize, LDS_BYTES) != hipSuccess) { fprintf(stderr, "kernel_launch: hipFuncSetAttribute failed\n"); grid = -1; return; }
        int per_cu = 0;
        if (hipOccupancyMaxActiveBlocksPerMultiprocessor(&per_cu, (const void*)mk_fwd, NTHR, LDS_BYTES) != hipSuccess || per_cu < 1) fprintf(stderr, "kernel_launch: occupancy query reports %d\n", per_cu);
        (void)hipGetLastError();
        grid = 256;
    }
    if (grid < 0) return;
    if (hipMemsetAsync((char*)d_ws + WS_CTL, 0, CTL_ZERO_BYTES, stream) != hipSuccess) { fprintf(stderr, "kernel_launch: memset failed\n"); return; }
    Args a{};
    for (int i = 0; i < 26; ++i) a.in[i] = d_in[i];
    a.out = (float*)d_out; a.ws = (unsigned char*)d_ws;
#if MK_ONE_LAUNCH
    a.ph_lo = 0; a.ph_hi = NPH;
    hipLaunchKernelGGL(mk_fwd, dim3(grid), dim3(NTHR), LDS_BYTES, stream, a);
#else
    for (int p = 0; p < NPH; ++p) {
        if (p >= 1 && p < NPH - 1) { const int l = (p - 1) / 10, j = (p - 1) % 10; if ((l & 1) && j == 4) continue; }
        a.ph_lo = p; a.ph_hi = p + 1;
        hipLaunchKernelGGL(mk_fwd, dim3(grid), dim3(NTHR), LDS_BYTES, stream, a);
    }
#endif
    const hipError_t le = hipPeekAtLastError();
    if (le != hipSuccess) fprintf(stderr, "kernel_launch: launch failed: %s\n", hipGetErrorName(le));
}
```

```cpp
#include <hip/hip_runtime.h>
#include <cstdio>
#include <cstdint>
namespace pg8 {
#define PG8_LAS __attribute__((address_space(3)))
typedef unsigned short bf16_t;
typedef short bf16x8 __attribute__((ext_vector_type(8)));
typedef float f32x4 __attribute__((ext_vector_type(4)));
typedef unsigned u32x4 __attribute__((ext_vector_type(4)));
constexpr int BM = 256, BK = 64, HALF = 128, HTB = HALF * BK * 2  , STAGE_BYTES = 8 * HTB, NXCD = 8, WGM = 8;

__host__ __device__ __forceinline__ int lds_byte(int r, int c) { const int st = (r >> 4) * 2 + (c >> 5), rr = r & 15, cc = c & 31, ob = rr * 64 + cc * 2; return st * 1024 + (ob ^ (((ob >> 9) & 1) << 5)); }
__host__ __device__ __forceinline__ void stage_rc(int b, int& R, int& C) { const int st = b / 1024, sb = b % 1024, swz = sb ^ (((sb >> 9) & 1) << 5); R = (st >> 1) * 16 + swz / 64; C = (st & 1) * 32 + (swz % 64) / 2; }
__host__ __device__ __forceinline__ int perm32(int rho) { const int n = rho >> 4, i = rho & 15; return 8 * (i >> 2) + 4 * n + (i & 3); }

struct Unit { int pm, pn; };
struct Gemm { const bf16_t* A; const bf16_t* Bt; int M, N, K; };

struct StaticOrder {
    int nM, nN, nwg, G, c;
    __host__ __device__ void init(int M, int N, int G_, int c_) { nM = M / BM; nN = N / BM; nwg = nM * nN; G = G_; c = c_; }
    __host__ __device__ bool next(int i, Unit& u) const {
        const long L = (long)i * G + c; if (L >= nwg) return false;
        int wgid = (int)L; { const int q = nwg / NXCD, r = nwg % NXCD, xcd = wgid % NXCD, off = wgid / NXCD; wgid = (xcd < r ? xcd * (q + 1) : r * (q + 1) + (xcd - r) * q) + off; }
        const int nig = WGM * nN, gid = wgid / nig, fm = gid * WGM, gsz = (nM - fm) < WGM ? (nM - fm) : WGM;
        u.pm = fm + ((wgid % nig) % gsz); u.pn = (wgid % nig) / gsz; return true;
    }
    __device__ __forceinline__ void a_ready(const Unit&) const {}
    __device__ __forceinline__ void done(const Unit&) const {}
};

__device__ __forceinline__ unsigned cvt_pk_bf16(float lo, float hi) { unsigned r; asm volatile("v_cvt_pk_bf16_f32 %0, %1, %2" : "=v"(r) : "v"(lo), "v"(hi)); return r; }
typedef float f32x2 __attribute__((ext_vector_type(2)));
__device__ __forceinline__ float swz_xor16(float v) { return __builtin_bit_cast(float, __builtin_amdgcn_ds_swizzle(__builtin_bit_cast(int, v), (16 << 10) | 0x1F)); }
__device__ __forceinline__ float fast_exp(float x) { return __builtin_amdgcn_exp2f(x * 1.4426950408889634f); }
__device__ __forceinline__ float fast_silu(float x) { return x * __builtin_amdgcn_rcpf(1.0f + fast_exp(-x)); }

template <bool NT, bool SC = false> struct EpiStoreT {
    static constexpr bool PERM = true, AFTER_DRAIN = false;
    bf16_t* O; int ldc; int nN; float sc;
    __device__ __forceinline__ void operator()(const f32x4 (&acc)[2][2][4][2], const Unit& u, int wr, int wc, int fr, int fq) const {
        int pm_ = u.pm; asm volatile("" : "+s"(pm_));
        const int row0 = pm_ * BM + wr * 64 + fr; const int col0 = (u.pn % nN) * BM + wc * 32 + 8 * fq;
#pragma unroll
        for (int ai = 0; ai < 2; ++ai)
#pragma unroll
            for (int m = 0; m < 4; ++m) { bf16_t* rowp = O + (size_t)(row0 + ai * HALF + m * 16) * ldc + col0;
#pragma unroll
                for (int bj = 0; bj < 2; ++bj) { f32x4 v0 = acc[ai][bj][m][0], v1 = acc[ai][bj][m][1];
                    if constexpr (SC) { v0 = v0 * sc; v1 = v1 * sc; }
                    u32x4 w; w.x = cvt_pk_bf16(v0[0], v0[1]); w.y = cvt_pk_bf16(v0[2], v0[3]); w.z = cvt_pk_bf16(v1[0], v1[1]); w.w = cvt_pk_bf16(v1[2], v1[3]);
                    if constexpr (NT) __builtin_nontemporal_store(w, (u32x4*)(rowp + bj * HALF)); else *(u32x4*)(rowp + bj * HALF) = w; } }
    }
};
typedef EpiStoreT<false> EpiStore;

struct EpiZe {
    static constexpr bool PERM = true, AFTER_DRAIN = false;
    bf16_t* O; int ldc;
    __device__ __forceinline__ void operator()(const f32x4 (&acc)[2][2][4][2], const Unit& u, int wr, int wc, int fr, int fq) const {
        int pm_ = u.pm; asm volatile("" : "+s"(pm_));
        const int row0 = pm_ * BM + wr * 64 + fr;
        if (u.pn < 7) {
            const int col0 = u.pn * BM + wc * 32 + 8 * fq;
#pragma unroll
            for (int ai = 0; ai < 2; ++ai)
#pragma unroll
                for (int m = 0; m < 4; ++m) { bf16_t* rowp = O + (size_t)(row0 + ai * HALF + m * 16) * ldc + col0;
#pragma unroll
                    for (int bj = 0; bj < 2; ++bj) { const f32x4 v0 = acc[ai][bj][m][0], v1 = acc[ai][bj][m][1];
                        u32x4 w; w.x = cvt_pk_bf16(v0[0], v0[1]); w.y = cvt_pk_bf16(v0[2], v0[3]); w.z = cvt_pk_bf16(v1[0], v1[1]); w.w = cvt_pk_bf16(v1[2], v1[3]);
                        __builtin_nontemporal_store(w, (u32x4*)(rowp + bj * HALF)); } }
        } else {
            const int col0 = 1792 + (u.pn - 7) * 128 + wc * 32 + 8 * fq;
#pragma unroll
            for (int ai = 0; ai < 2; ++ai)
#pragma unroll
                for (int m = 0; m < 4; ++m) {
                    const f32x4 a0 = acc[ai][0][m][0], a1 = acc[ai][0][m][1], b0 = acc[ai][1][m][0], b1 = acc[ai][1][m][1];
                    f32x4 g0, g1;
#pragma unroll
                    for (int i = 0; i < 4; ++i) { g0[i] = a0[i] * __builtin_amdgcn_rcpf(1.0f + fast_exp(-b0[i])); g1[i] = a1[i] * __builtin_amdgcn_rcpf(1.0f + fast_exp(-b1[i])); }
                    u32x4 w; w.x = cvt_pk_bf16(g0[0], g0[1]); w.y = cvt_pk_bf16(g0[2], g0[3]); w.z = cvt_pk_bf16(g1[0], g1[1]); w.w = cvt_pk_bf16(g1[2], g1[3]);
                    __builtin_nontemporal_store(w, (u32x4*)(O + (size_t)(row0 + ai * HALF + m * 16) * ldc + col0)); }
        }
    }
};

struct EpiStoreDn {
    static constexpr bool PERM = true, AFTER_DRAIN = false;
    unsigned char* O;
    __device__ __forceinline__ void operator()(const f32x4 (&acc)[2][2][4][2], const Unit& u, int wr, int wc, int fr, int fq) const {
        int pm_ = u.pm; asm volatile("" : "+s"(pm_));
        const int row0 = pm_ * BM + wr * 64 + fr; const int col0 = (u.pn & 3) * BM + wc * 64 + 16 * fq;
#pragma unroll
        for (int ai = 0; ai < 2; ++ai)
#pragma unroll
            for (int m = 0; m < 4; ++m) { u32x4 w;
#pragma unroll
                for (int bj = 0; bj < 2; ++bj) { const f32x4 v0 = acc[ai][bj][m][0] * 0.5f, v1 = acc[ai][bj][m][1] * 0.5f;
                    float q0[4], q1[4];
#pragma unroll
                    for (int i = 0; i < 4; ++i) { q0[i] = __builtin_amdgcn_fmed3f(v0[i], -448.f, 448.f); q1[i] = __builtin_amdgcn_fmed3f(v1[i], -448.f, 448.f); }
                    int t0_ = 0, t1_ = 0;
                    t0_ = __builtin_amdgcn_cvt_pk_fp8_f32(q0[0], q0[1], t0_, false); t0_ = __builtin_amdgcn_cvt_pk_fp8_f32(q0[2], q0[3], t0_, true);
                    t1_ = __builtin_amdgcn_cvt_pk_fp8_f32(q1[0], q1[1], t1_, false); t1_ = __builtin_amdgcn_cvt_pk_fp8_f32(q1[2], q1[3], t1_, true);
                    if (bj == 0) { w.x = (unsigned)t0_; w.y = (unsigned)t1_; } else { w.z = (unsigned)t0_; w.w = (unsigned)t1_; } }
                __builtin_nontemporal_store(w, (u32x4*)(O + (size_t)(row0 + ai * HALF + m * 16) * 1024 + col0)); }
    }
};

struct EpiQkv {
    static constexpr bool PERM = true, AFTER_DRAIN = false;
    bf16_t* O; int ldc; const PG8_LAS float* cs; float wscale;
    __device__ __forceinline__ void operator()(const f32x4 (&acc)[2][2][4][2], const Unit& u, int wr, int wc, int fr, int fq) const {
        int pm_ = u.pm; asm volatile("" : "+s"(pm_));
        const int row0 = pm_ * BM + wr * 64 + fr;
        const size_t img = (size_t)(u.pn >> 2) * ((size_t)65536 * 1024); const int head0 = (u.pn & 3) * 4 + (wc >> 1), d0 = (wc & 1) * 32 + 8 * fq;
        const bool roped = (u.pn < 8) && ((wc & 1) == 0);
        const float qs = ((u.pn < 4) ? 0.125f * 1.4426950408889634f : 1.0f) * wscale;
        const float sgn = (fq == 0) ? -1.0f : 1.0f;
#pragma unroll
        for (int ai = 0; ai < 2; ++ai)
#pragma unroll
            for (int m = 0; m < 4; ++m) { const int row = row0 + ai * HALF + m * 16; const int bb = row >> 13, ss = row & 8191;
                f32x4 c0 = {1.f, 1.f, 1.f, 1.f}, c1 = c0, s0 = {0.f, 0.f, 0.f, 0.f}, s1 = s0;
                if (roped) { const PG8_LAS f32x4* cp = (const PG8_LAS f32x4*)(cs + (wr * 64 + fr + ai * HALF + m * 16) * 16); c0 = cp[0]; c1 = cp[1]; s0 = cp[2]; s1 = cp[3]; }
#pragma unroll
                for (int bj = 0; bj < 2; ++bj) { f32x4 v0 = acc[ai][bj][m][0], v1 = acc[ai][bj][m][1];
                    if (roped) {
                        f32x4 p0, p1;
#pragma unroll
                        for (int i = 0; i < 4; ++i) { p0[i] = swz_xor16(v0[i]); p1[i] = swz_xor16(v1[i]); }
                        if (fq < 2) { v0 = v0 * c0 + (p0 * s0) * sgn; v1 = v1 * c1 + (p1 * s1) * sgn; }
                    }
                    v0 = v0 * qs; v1 = v1 * qs;
                    u32x4 w; w.x = cvt_pk_bf16(v0[0], v0[1]); w.y = cvt_pk_bf16(v0[2], v0[3]); w.z = cvt_pk_bf16(v1[0], v1[1]); w.w = cvt_pk_bf16(v1[2], v1[3]);
                    __builtin_nontemporal_store(w, (u32x4*)(O + img + ((size_t)((bb * 16 + head0 + 2 * bj) * 8192 + ss)) * 64 + d0)); }
                __builtin_amdgcn_sched_barrier(0); }
    }
};

struct EpiSwiglu {
    static constexpr bool PERM = true, AFTER_DRAIN = false;
    bf16_t* O;
    float wscale;
    __device__ __forceinline__ void operator()(const f32x4 (&acc)[2][2][4][2], const Unit& u, int wr, int wc, int fr, int fq) const {
        const int row0 = u.pm * BM + wr * 64 + fr; const int col0 = (u.pn & 3) * 128 + wc * 32 + 8 * fq;
#pragma unroll
        for (int ai = 0; ai < 2; ++ai)
#pragma unroll
            for (int m = 0; m < 4; ++m) {
                const f32x4 a0 = acc[ai][0][m][0], a1 = acc[ai][0][m][1], b0 = acc[ai][1][m][0], b1 = acc[ai][1][m][1];
                f32x4 h0, h1;
#pragma unroll
                for (int i = 0; i < 4; ++i) { h0[i] = fast_silu(a0[i] * wscale) * (b0[i] * wscale); h1[i] = fast_silu(a1[i] * wscale) * (b1[i] * wscale); }
                typedef unsigned u32x2_ __attribute__((ext_vector_type(2)));
                u32x2_ w; { int t0_ = 0, t1_ = 0;
                    float q0[4], q1[4];
#pragma unroll
                    for (int i = 0; i < 4; ++i) { q0[i] = __builtin_amdgcn_fmed3f(h0[i], -448.f, 448.f); q1[i] = __builtin_amdgcn_fmed3f(h1[i], -448.f, 448.f); }
                    t0_ = __builtin_amdgcn_cvt_pk_fp8_f32(q0[0], q0[1], t0_, false); t0_ = __builtin_amdgcn_cvt_pk_fp8_f32(q0[2], q0[3], t0_, true);
                    t1_ = __builtin_amdgcn_cvt_pk_fp8_f32(q1[0], q1[1], t1_, false); t1_ = __builtin_amdgcn_cvt_pk_fp8_f32(q1[2], q1[3], t1_, true);
                    w.x = (unsigned)t0_; w.y = (unsigned)t1_; }
                *(u32x2_*)((unsigned char*)O + (size_t)(row0 + ai * HALF + m * 16) * 512 + col0) = w; }
    }
};

struct GroupOrder {
    const PG8_LAS int* tstart; int G, v; int cape;
    __device__ __forceinline__ long gather_off(const Unit& u) const { const int e = u.pn >> 2; return (long)e * cape - (long)tstart[e] * BM; }
    __device__ __forceinline__ bool next(int i, Unit& u) const {
        const int L = i * G + v; const int nt = tstart[32];
        if (L >= nt * 4) return false;
        const int pm = L >> 2; int e = 0;
#pragma unroll
        for (int k = 1; k < 32; ++k) e += (tstart[k] <= pm) ? 1 : 0;
        u.pm = __builtin_amdgcn_readfirstlane(pm); u.pn = __builtin_amdgcn_readfirstlane(e * 4 + (L & 3)); return true;
    }
    __device__ __forceinline__ void a_ready(const Unit&) const {}
    __device__ __forceinline__ void done(const Unit&) const {}
};

struct PanelOrder {
    int pm, nN;
    __device__ __forceinline__ bool next(int i, Unit& u) const { if (i >= nN) return false; u.pm = pm; u.pn = i; return true; }
    __device__ __forceinline__ void a_ready(const Unit&) const {}
    __device__ __forceinline__ void done(const Unit&) const {}
};

template <class Epi, class Sched, bool ALIGN_EPI = false, bool SP2 = false, bool GATHER = false, bool F8 = false>
__device__ __forceinline__ void gemm_phase(PG8_LAS unsigned char* lds, const Gemm g, const Sched& S, const Epi& E, const int wave_in, const int* rowidx = nullptr, const unsigned nrows = 0) {
    static_assert(!GATHER || SP2, "GATHER is implemented for the SP2 loop");
    int tid_; asm volatile("v_mbcnt_lo_u32_b32 %0, -1, 0\n\tv_mbcnt_hi_u32_b32 %0, -1, %0" : "=v"(tid_)); tid_ += wave_in * 64;
    const int tid = tid_, wid = __builtin_amdgcn_readfirstlane(tid >> 6), lane = tid & 63, wr = wid >> 2, wc = wid & 3, fr = lane & 15, fq = lane >> 4;
    const int K = g.K, nt = K / BK;
    unsigned voffA[2], voffB[2];
#pragma unroll
    for (int i = 0; i < 2; ++i) { int R, C; stage_rc(tid * 16 + i * 8192, R, C); const int Rb = Epi::PERM ? ((R & ~31) + perm32(R & 31)) : R;
        voffA[i] = (unsigned)(R * K + C) * 2u; voffB[i] = (unsigned)(Rb * K + C) * 2u; }
    int sR[2], sC[2];
#pragma unroll
    for (int i = 0; i < 2; ++i) stage_rc(tid * 16 + i * 8192, sR[i], sC[i]);
    unsigned ga[2][2];
#define PG8_GOFF(dst, pm_)    do { _Pragma("unroll") for (int h_ = 0; h_ < 2; ++h_) _Pragma("unroll") for (int i_ = 0; i_ < 2; ++i_) { \
        unsigned r_ = (unsigned)rowidx[S.gather_off(pm_) + (long)(pm_).pm * BM + h_ * HALF + sR[i_]]; r_ = r_ < nrows ? r_ : nrows - 1u; dst[h_][i_] = (r_ * (unsigned)K + (unsigned)sC[i_]) * 2u; } } while (0)
#define PG8_STAGE_GA(bufoff, kbyte, h) do { _Pragma("unroll") for (int _i = 0; _i < 2; ++_i) { unsigned vo_ = ga[h][_i]; asm volatile("" : "+v"(vo_)); \
        __builtin_amdgcn_global_load_lds((const unsigned*)((const char*)g.A + (size_t)(kbyte) + vo_), (PG8_LAS unsigned*)(lds + (bufoff) + ldsw + _i * 8192), 16, 0, 0); } } while (0)
    const size_t kstep = (size_t)(BK * 2);
    const size_t hstep = (size_t)HALF * K * 2;
    const size_t tstep = 2 * hstep;
    const unsigned ldsw = (unsigned)wid * 1024u;
    const int aoff = lds_byte(wr * 64 + fr, fq * 8), boff = lds_byte(wc * 32 + fr, fq * 8);
#define PG8_SA(b, h) (((b) * 2 + (h)) * HTB)
#define PG8_SB(b, h) ((4 + (b) * 2 + (h)) * HTB)
#define PG8_STAGE(bufoff, gbase, voff) do { _Pragma("unroll") for (int _i = 0; _i < 2; ++_i) { unsigned vo_ = (voff)[_i]; asm volatile("" : "+v"(vo_));     \
        __builtin_amdgcn_global_load_lds((const unsigned*)((const char*)(gbase) + vo_), (PG8_LAS unsigned*)(lds + (bufoff) + ldsw + _i * 8192), 16, 0, 0); } } while (0)
#define PG8_LDA(dst, b, h) do { _Pragma("unroll") for (int m = 0; m < 4; ++m) _Pragma("unroll") for (int k = 0; k < 2; ++k) dst[m][k] = *(const PG8_LAS bf16x8*)(lds + PG8_SA(b, h) + aoff + m * 2048 + k * 1024); } while (0)
#define PG8_LDB(dst, b, h) do { _Pragma("unroll") for (int n = 0; n < 2; ++n) _Pragma("unroll") for (int k = 0; k < 2; ++k) dst[n][k] = *(const PG8_LAS bf16x8*)(lds + PG8_SB(b, h) + boff + n * 2048 + k * 1024); } while (0)
#define PG8_MMA(ai, bj, At, Bt) do { __builtin_amdgcn_s_setprio(1); _Pragma("unroll") for (int m = 0; m < 4; ++m) _Pragma("unroll") for (int n = 0; n < 2; ++n) _Pragma("unroll") for (int k = 0; k < 2; ++k) { \
        if constexpr (F8) { if (k == 0) { typedef int i4_t __attribute__((ext_vector_type(4))); \
            acc[ai][bj][m][n] = __builtin_amdgcn_mfma_scale_f32_16x16x128_f8f6f4(__builtin_shufflevector(__builtin_bit_cast(i4_t, Bt[n][0]), __builtin_bit_cast(i4_t, Bt[n][1]), 0, 1, 2, 3, 4, 5, 6, 7), \
                __builtin_shufflevector(__builtin_bit_cast(i4_t, At[m][0]), __builtin_bit_cast(i4_t, At[m][1]), 0, 1, 2, 3, 4, 5, 6, 7), acc[ai][bj][m][n], 0, 0, 0, 0, 0, 0); } } \
        else acc[ai][bj][m][n] = __builtin_amdgcn_mfma_f32_16x16x32_bf16(Bt[n][k], At[m][k], acc[ai][bj][m][n], 0, 0, 0); } __builtin_amdgcn_s_setprio(0); } while (0)
#define PG8_WAIT_V(n) asm volatile("s_waitcnt vmcnt(" #n ")" ::: "memory")
#define PG8_WAIT_L(n) asm volatile("s_waitcnt lgkmcnt(" #n ")" ::: "memory")
#define PG8_BAR __builtin_amdgcn_s_barrier()
#define PG8_SCHED __builtin_amdgcn_sched_barrier(0)
    Unit cur, nxt; int ui = 0;
    if (!S.next(0, cur)) return;
    f32x4 acc[2][2][4][2];
#pragma unroll
    for (int a = 0; a < 2; ++a)
#pragma unroll
        for (int b = 0; b < 2; ++b)
#pragma unroll
            for (int m = 0; m < 4; ++m)
#pragma unroll
                for (int n = 0; n < 2; ++n) acc[a][b][m][n] = (f32x4){0.f, 0.f, 0.f, 0.f};
    bf16x8 At[4][2], B0[2][2], B1[2][2];
    const char* cA = (const char*)g.A + (size_t)cur.pm * tstep; const char* cB = (const char*)g.Bt + (size_t)cur.pn * tstep;
    S.a_ready(cur);
    if constexpr (SP2) {
        if constexpr (GATHER) { PG8_GOFF(ga, cur);
        PG8_STAGE(PG8_SB(0, 0), cB, voffB); PG8_STAGE(PG8_SB(0, 1), cB + hstep, voffB); PG8_STAGE_GA(PG8_SA(0, 0), 0, 0); PG8_STAGE_GA(PG8_SA(0, 1), 0, 1);
        } else {
        PG8_STAGE(PG8_SB(0, 0), cB, voffB); PG8_STAGE(PG8_SB(0, 1), cB + hstep, voffB); PG8_STAGE(PG8_SA(0, 0), cA, voffA); PG8_STAGE(PG8_SA(0, 1), cA + hstep, voffA); }
        if (wr == 1) PG8_BAR;
        PG8_WAIT_V(2); PG8_BAR;
        if constexpr (GATHER) { PG8_STAGE(PG8_SB(1, 0), cB + kstep, voffB); PG8_STAGE_GA(PG8_SA(1, 0), kstep, 0); PG8_STAGE(PG8_SB(1, 1), cB + hstep + kstep, voffB); } else {
        PG8_STAGE(PG8_SB(1, 0), cB + kstep, voffB); PG8_STAGE(PG8_SA(1, 0), cA + kstep, voffA); PG8_STAGE(PG8_SB(1, 1), cB + hstep + kstep, voffB); }
        PG8_WAIT_V(6); PG8_BAR;
    } else {
        PG8_STAGE(PG8_SB(0, 0), cB, voffB); PG8_STAGE(PG8_SA(0, 0), cA, voffA); PG8_STAGE(PG8_SB(0, 1), cB + hstep, voffB); PG8_STAGE(PG8_SA(0, 1), cA + hstep, voffA);
        if (wr == 1) PG8_BAR;
        PG8_WAIT_V(4); PG8_BAR;
        PG8_STAGE(PG8_SB(1, 0), cB + kstep, voffB); PG8_STAGE(PG8_SA(1, 0), cA + kstep, voffA); PG8_STAGE(PG8_SB(1, 1), cB + hstep + kstep, voffB);
        PG8_WAIT_V(6); PG8_BAR;
    }
    for (;;) {
        const bool has_next = S.next(ui + 1, nxt);
        unsigned gn[2][2];
        if constexpr (GATHER) { if (has_next) PG8_GOFF(gn, nxt); else { _Pragma("unroll") for (int h_ = 0; h_ < 2; ++h_) _Pragma("unroll") for (int i_ = 0; i_ < 2; ++i_) gn[h_][i_] = ga[h_][i_]; } }
        const char* nA = has_next ? (const char*)g.A + (size_t)nxt.pm * tstep : cA; const char* nB = has_next ? (const char*)g.Bt + (size_t)nxt.pn * tstep : cB;
        for (int t = 0; t < nt; t += 2) {
            const bool last = (t == nt - 2);
            const char* a1 = cA + (size_t)(t + 1) * kstep;
            const char* a2 = last ? nA : cA + (size_t)(t + 2) * kstep; const char* b2 = last ? nB : cB + (size_t)(t + 2) * kstep;
            const char* a3 = a2 + kstep; const char* b3 = b2 + kstep;
            if (last && has_next) S.a_ready(nxt);
            if constexpr (SP2) {
            const size_t kb2 = last ? (size_t)0 : (size_t)(t + 2) * kstep;
            PG8_LDB(B0, 0, 0); PG8_LDB(B1, 0, 1); PG8_SCHED; PG8_LDA(At, 0, 0);
            if constexpr (GATHER) { PG8_STAGE_GA(PG8_SA(1, 1), (size_t)(t + 1) * kstep, 1);
                if (last) { _Pragma("unroll") for (int h_ = 0; h_ < 2; ++h_) _Pragma("unroll") for (int i_ = 0; i_ < 2; ++i_) ga[h_][i_] = gn[h_][i_]; } }
            else PG8_STAGE(PG8_SA(1, 1), a1 + hstep, voffA);
            PG8_WAIT_V(8); PG8_WAIT_L(0); PG8_BAR; PG8_MMA(0, 0, At, B0); PG8_MMA(0, 1, At, B1); PG8_BAR; PG8_SCHED;
            PG8_LDA(At, 0, 1); PG8_STAGE(PG8_SB(0, 0), b2, voffB); PG8_STAGE(PG8_SB(0, 1), b2 + hstep, voffB);
            if constexpr (GATHER) PG8_STAGE_GA(PG8_SA(0, 0), kb2, 0); else PG8_STAGE(PG8_SA(0, 0), a2, voffA);
            PG8_WAIT_V(8); PG8_WAIT_L(0); PG8_BAR; PG8_MMA(1, 0, At, B0); PG8_MMA(1, 1, At, B1); PG8_BAR; PG8_SCHED;
            PG8_LDB(B0, 1, 0); PG8_LDB(B1, 1, 1); PG8_SCHED; PG8_LDA(At, 1, 0);
            if constexpr (GATHER) PG8_STAGE_GA(PG8_SA(0, 1), kb2, 1); else PG8_STAGE(PG8_SA(0, 1), a2 + hstep, voffA);
            PG8_WAIT_V(8); PG8_WAIT_L(0); PG8_BAR; PG8_MMA(0, 0, At, B0); PG8_MMA(0, 1, At, B1); PG8_BAR; PG8_SCHED;
            PG8_LDA(At, 1, 1); PG8_STAGE(PG8_SB(1, 0), b3, voffB); PG8_STAGE(PG8_SB(1, 1), b3 + hstep, voffB);
            if constexpr (GATHER) PG8_STAGE_GA(PG8_SA(1, 0), kb2 + kstep, 0); else PG8_STAGE(PG8_SA(1, 0), a3, voffA);
            PG8_WAIT_V(8); PG8_WAIT_L(0); PG8_BAR; PG8_MMA(1, 0, At, B0); PG8_MMA(1, 1, At, B1); PG8_BAR; PG8_SCHED;
            } else {
            PG8_LDB(B0, 0, 0); PG8_SCHED; PG8_LDA(At, 0, 0); PG8_STAGE(PG8_SA(1, 1), a1 + hstep, voffA);
            PG8_WAIT_L(8); PG8_BAR; PG8_WAIT_L(0); PG8_MMA(0, 0, At, B0); PG8_BAR; PG8_SCHED;
            PG8_LDB(B1, 0, 1); PG8_STAGE(PG8_SB(0, 0), b2, voffB);
            PG8_BAR; PG8_WAIT_L(0); PG8_MMA(0, 1, At, B1); PG8_BAR;
            PG8_LDA(At, 0, 1); PG8_STAGE(PG8_SA(0, 0), a2, voffA);
            PG8_BAR; PG8_WAIT_L(0); PG8_MMA(1, 0, At, B0); PG8_BAR; PG8_SCHED;
            PG8_STAGE(PG8_SB(0, 1), b2 + hstep, voffB);
            PG8_WAIT_V(6); PG8_BAR; PG8_MMA(1, 1, At, B1); PG8_BAR;
            PG8_LDB(B0, 1, 0); PG8_SCHED; PG8_LDA(At, 1, 0); PG8_STAGE(PG8_SA(0, 1), a2 + hstep, voffA);
            PG8_WAIT_L(8); PG8_BAR; PG8_WAIT_L(0); PG8_MMA(0, 0, At, B0); PG8_BAR; PG8_SCHED;
            PG8_LDB(B1, 1, 1); PG8_STAGE(PG8_SB(1, 0), b3, voffB);
            PG8_BAR; PG8_WAIT_L(0); PG8_MMA(0, 1, At, B1); PG8_BAR;
            PG8_LDA(At, 1, 1); PG8_STAGE(PG8_SA(1, 0), a3, voffA);
            PG8_BAR; PG8_WAIT_L(0); PG8_MMA(1, 0, At, B0); PG8_BAR; PG8_SCHED;
            PG8_STAGE(PG8_SB(1, 1), b3 + hstep, voffB);
            PG8_WAIT_V(6); PG8_BAR; PG8_MMA(1, 1, At, B1); PG8_BAR;
            }
        }
        if constexpr (ALIGN_EPI) { if (wr == 0) PG8_BAR; }
        if constexpr (!Epi::AFTER_DRAIN) { int fr_ = fr, fq_ = fq; asm volatile("" : "+v"(fr_), "+v"(fq_));
            E(acc, cur, wr, wc, fr_, fq_); S.done(cur); }
        if (!has_next) break;
#pragma unroll
        for (int a = 0; a < 2; ++a)
#pragma unroll
            for (int b = 0; b < 2; ++b)
#pragma unroll
                for (int m = 0; m < 4; ++m)
#pragma unroll
                    for (int n = 0; n < 2; ++n) acc[a][b][m][n] = (f32x4){0.f, 0.f, 0.f, 0.f};
        cur = nxt; cA = nA; cB = nB; ++ui;
        if constexpr (ALIGN_EPI) { if (wr == 1) PG8_BAR; }
    }
    PG8_WAIT_V(0);
    if constexpr (!ALIGN_EPI) { if (wr == 0) PG8_BAR; }
    PG8_BAR;
    if constexpr (Epi::AFTER_DRAIN) { E.fused(acc, cur, wr, wc, fr, fq, lds, wid, lane); S.done(cur); }
#undef PG8_SA
#undef PG8_SB
#undef PG8_STAGE
#undef PG8_STAGE_GA
#undef PG8_GOFF
#undef PG8_LDA
#undef PG8_LDB
#undef PG8_MMA
#undef PG8_WAIT_V
#undef PG8_WAIT_L
#undef PG8_BAR
#undef PG8_SCHED
}
}
typedef short v4i16_t __attribute__((ext_vector_type(4)));
#define GAS __attribute__((address_space(1)))
#define LAS __attribute__((address_space(3)))
typedef unsigned short bf16;
typedef unsigned v4u __attribute__((ext_vector_type(4)));
typedef float f32x4 __attribute__((ext_vector_type(4)));
typedef short bf16x8 __attribute__((ext_vector_type(8)));
typedef GAS unsigned gu32;
typedef GAS unsigned long long gu64;
#define RLX_AGENT __ATOMIC_RELAXED, __HIP_MEMORY_SCOPE_AGENT
#define LDS_WAIT() asm volatile("s_waitcnt lgkmcnt(0)" ::: "memory")
#define VM_WAIT() asm volatile("s_waitcnt vmcnt(0)" ::: "memory")
__device__ __forceinline__ unsigned long long rt() { return __builtin_amdgcn_s_memrealtime(); }
__device__ __forceinline__ unsigned f2bf(float f) { unsigned u = __builtin_bit_cast(unsigned, f); return (u + 0x7fffu + ((u >> 16) & 1u)) >> 16; }
typedef float f32x2_t_ __attribute__((ext_vector_type(2))); typedef __bf16 bf16x2_t_ __attribute__((ext_vector_type(2)));
__device__ __forceinline__ unsigned pk2(float lo, float hi) { const f32x2_t_ v = {lo, hi}; return __builtin_bit_cast(unsigned, __builtin_convertvector(v, bf16x2_t_)); }

#define XB_TMO      128
#define XB_XCNT(j)  (256  + 64 * (j))
#define XB_XSUB(j)  (1280 + 64 * (j))
#define XB_XGEN(j)  (2304 + 64 * (j))
#define XB_TOP      3328
#define XB_TOPGEN   3392
#define XCD_BAR_WORDS 3456
#define XB_SPIN_CAP (1u << 18)

__device__ __forceinline__ unsigned xb_ld(unsigned* p)              { return __hip_atomic_load(p, __ATOMIC_RELAXED, __HIP_MEMORY_SCOPE_AGENT); }
__device__ __forceinline__ unsigned xb_add(unsigned* p, unsigned v) { return __hip_atomic_fetch_add(p, v, __ATOMIC_RELAXED, __HIP_MEMORY_SCOPE_AGENT); }
__device__ __forceinline__ unsigned xb_xcc_id() { return (unsigned)__builtin_amdgcn_s_getreg((3 << 11) | 20) & 0xFu; }
#define XB_SPIN(cond, bar) do { unsigned _sp = 0; while (cond) { __builtin_amdgcn_s_sleep(1); \
    if ((++_sp & 255u) == 0u) { if (xb_ld(&(bar)[XB_TMO])) break; if (_sp > XB_SPIN_CAP) { atomicAdd(&(bar)[XB_TMO], 1u); break; } } } } while (0)

struct XcdBarrier {
    unsigned* bar; unsigned x;
    volatile LAS unsigned* st;
};

__device__ __forceinline__ XcdBarrier xcd_barrier_post(unsigned* bar, volatile LAS unsigned* st) {
    XcdBarrier b; b.bar = bar; b.x = xb_xcc_id(); b.st = st;
    if (threadIdx.x == 0) (void)xb_add(&bar[XB_XCNT(b.x)], 1u);
    return b;
}
__device__ __forceinline__ void xcd_barrier_complete(unsigned* bar, unsigned x, unsigned& nloc, unsigned& nx) {
    const unsigned G = gridDim.x * gridDim.y * gridDim.z;
    unsigned sum, cnt, mine, sp = 0u;
    for (;;) {
        sum = 0u; cnt = 0u; mine = 0u;
#pragma unroll
        for (unsigned j = 0; j < 16; ++j) { const unsigned c = xb_ld(&bar[XB_XCNT(j)]); sum += c; cnt += (c > 0u) ? 1u : 0u; mine = (j == x) ? c : mine; }
        if (sum == G) break;
        __builtin_amdgcn_s_sleep(1);
        if ((++sp & 255u) == 0u) { if (xb_ld(&bar[XB_TMO])) break; if (sp > XB_SPIN_CAP) { atomicAdd(&bar[XB_TMO], 1u); break; } }
    }
    nloc = mine > 0u ? mine : 1u; nx = cnt > 0u ? cnt : 1u;
}

__device__ __forceinline__ void xcd_barrier(const XcdBarrier& b, const bool lead) {
    asm volatile("s_waitcnt vmcnt(0)" ::: "memory");
    __syncthreads();
    if (lead) {
        unsigned* bar = b.bar;
        __builtin_amdgcn_s_waitcnt(0);
        unsigned nloc = b.st[0], nx = b.st[1];
        if (nloc == 0u) { xcd_barrier_complete(bar, b.x, nloc, nx); b.st[0] = nloc; b.st[1] = nx; }
        const unsigned old = xb_add(&bar[XB_XSUB(b.x)], 1u);
        const unsigned gen = old / nloc;
        if (old + 1u == (gen + 1u) * nloc) {
            __builtin_amdgcn_fence(__ATOMIC_RELEASE, "agent");
            asm volatile("s_waitcnt vmcnt(0)" ::: "memory");
            const unsigned og = xb_add(&bar[XB_TOP], 1u);
            const unsigned tg = og / nx;
            if (og + 1u == (tg + 1u) * nx) xb_add(&bar[XB_TOPGEN], 1u);
            else XB_SPIN(xb_ld(&bar[XB_TOPGEN]) == tg, bar);
            __builtin_amdgcn_fence(__ATOMIC_ACQUIRE, "agent");
            xb_add(&bar[XB_XGEN(b.x)], 1u);
            asm volatile("s_waitcnt vmcnt(0)" ::: "memory");
        } else {
            XB_SPIN(xb_ld(&bar[XB_XGEN(b.x)]) == gen, bar);
            __builtin_amdgcn_fence(__ATOMIC_ACQUIRE, "agent");
            asm volatile("s_waitcnt vmcnt(0)" ::: "memory");
        }
    }
    __syncthreads();
}

constexpr int NB = 8, SEQ = 8192, T = NB * SEQ, D = 1024, DEPTH = 4;
constexpr int ZE = 2304, ZEW = 2816, ZO = 3072;
constexpr int NEXP = 32, PMAX = 2 * T + NEXP * 256;
constexpr float NORM_EPS = 1e-6f;
constexpr float LOG2E = 1.4426950408889634f, LN2 = 0.6931471805599453f;
constexpr int NWAVES = 8, NTHR = 512;

constexpr size_t MiB = 1u << 20;
constexpr size_t WS_CTL = 0, CTL_ZERO_BYTES = 1 * MiB;
constexpr size_t WS_MOD = 1 * MiB;
constexpr size_t WS_TOKE = 2 * MiB;
constexpr size_t WS_TOKR = WS_TOKE + 512 * 1024;
constexpr size_t WS_TOKW = WS_TOKR + 512 * 1024;
constexpr size_t WS_TOKD = WS_TOKW + 512 * 1024;
constexpr size_t WS_ROWTOK = 4 * MiB;
constexpr size_t WS_DEC = 6 * MiB;
constexpr size_t WS_LSE = 7 * MiB;
constexpr size_t WS_CS = 19 * MiB;
constexpr size_t WS_WRT = 23 * MiB;
constexpr size_t WS_WIN = 24 * MiB;
constexpr size_t WS_WOE = 35 * MiB;
constexpr size_t WS_WQKV = 39 * MiB;
constexpr size_t WS_WOO = 51 * MiB;
constexpr size_t WS_W13 = 56 * MiB;
constexpr size_t WS_W2 = 88 * MiB;
constexpr size_t WS_H = 104 * MiB;
constexpr size_t WS_X1 = 232 * MiB;
constexpr size_t WS_Z = 360 * MiB;
constexpr size_t WS_HID = WS_Z;
constexpr size_t WS_YS = 744 * MiB;
constexpr size_t WS_M = WS_YS;
constexpr size_t WS_M8 = WS_Z;
constexpr size_t WS_H8 = WS_YS + 128 * MiB;
constexpr size_t WS_EXPTOK = WS_YS + (size_t)PMAX * 1024 * 2;
constexpr int CAPE = T + 256;
constexpr size_t WS_XH = WS_EXPTOK + 9 * MiB;
constexpr size_t WS_END = WS_XH + (size_t)T * 1024 * 2;
static_assert(WS_EXPTOK + (size_t)NEXP * CAPE * 4 <= WS_XH, "token lists");
static_assert(WS_H8 + (size_t)T * 1024 <= WS_EXPTOK && WS_M + (size_t)T * 1024 * 2 <= WS_H8, "h2 rows inside the ys region");
static_assert(WS_Z + (size_t)T * ZO * 2 <= WS_YS && WS_HID + (size_t)PMAX * 512 * 2 <= WS_YS && WS_END <= 1160 * MiB, "d_ws map");
constexpr int CW_CNT = 64;
constexpr int CW_BAR = 4096;

constexpr int LDS_BYTES = 152 * 1024;
constexpr int LDS_CSROWS = 128 * 1024;
constexpr int LDS_TAB = 148 * 1024;
constexpr int LDS_MISC = 150 * 1024;
constexpr int LDS_PHASE_MAX = 148 * 1024;

typedef short s16x4 __attribute__((ext_vector_type(4)));
typedef float f32x2 __attribute__((ext_vector_type(2)));
typedef unsigned v2u __attribute__((ext_vector_type(2)));
struct Frame {
    LAS unsigned char* lds;
    gu32* ctl;
    int tid, lane, wave, vcu, G;
    float* out; unsigned char* ws;
};
__device__ __forceinline__ const void* inptr_raw(int k) {
    const __attribute__((address_space(1))) void* p; const void* tab = (const void*)__builtin_amdgcn_kernarg_segment_ptr();
    asm volatile("s_load_dwordx2 %0, %1, %2\n\ts_waitcnt lgkmcnt(0)" : "=s"(p) : "s"(tab), "i"(k * 8) : "memory");
    return (const void*)p;
}
#define INF(k) ((const float*)inptr_raw(k))
enum { I_X = 0, I_C = 1, I_POS = 2, I_ADAW = 3, I_ADAB = 4, I_N1G = 5, I_N2G = 6, I_EWIN = 7, I_EWG2 = 8, I_EBG = 9, I_EGNG = 10, I_ECW = 11, I_ECB = 12, I_ELNG = 13, I_ELNB = 14,
       I_EWOUT = 15, I_OWQKV = 16, I_OWOUT = 17, I_MWGRP = 18, I_MBGRP = 19, I_MWRT = 20, I_MBRT = 21, I_MW1 = 22, I_MW3 = 23, I_MW2 = 24, I_FNG = 25 };

__device__ __forceinline__ float bf2f(unsigned h) { return __builtin_bit_cast(float, h << 16); }
__device__ __forceinline__ float bflo(unsigned w) { return __builtin_bit_cast(float, w << 16); }
__device__ __forceinline__ float bfhi(unsigned w) { return __builtin_bit_cast(float, w & 0xffff0000u); }
template <int X> __device__ __forceinline__ float swz_xor(float v) { return __builtin_bit_cast(float, __builtin_amdgcn_ds_swizzle(__builtin_bit_cast(int, v), (X << 10) | 0x1F)); }
typedef _Float16 h16x4 __attribute__((ext_vector_type(4)));
__device__ __forceinline__ f32x4 ldxh(const unsigned char* XH, size_t t, int c) { const v2u u = __builtin_nontemporal_load((const v2u*)(XH + (t * D + c) * 2)); return __builtin_convertvector(__builtin_bit_cast(h16x4, u), f32x4); }
__device__ __forceinline__ void stxh(unsigned char* XH, size_t t, int c, const f32x4 v) { __builtin_nontemporal_store(__builtin_bit_cast(v2u, __builtin_convertvector(v, h16x4)), (v2u*)(XH + (t * D + c) * 2)); }
__device__ __forceinline__ float rows4_max(float m) { const unsigned u = __builtin_bit_cast(unsigned, m);
    const auto r = __builtin_amdgcn_permlane16_swap(u, u, false, false); const float t = fmaxf(__builtin_bit_cast(float, (unsigned)r[0]), __builtin_bit_cast(float, (unsigned)r[1])); const unsigned v = __builtin_bit_cast(unsigned, t);
    const auto s = __builtin_amdgcn_permlane32_swap(v, v, false, false); return fmaxf(__builtin_bit_cast(float, (unsigned)s[0]), __builtin_bit_cast(float, (unsigned)s[1])); }
__device__ __forceinline__ float rows4_sum(float m) { const unsigned u = __builtin_bit_cast(unsigned, m);
    const auto r = __builtin_amdgcn_permlane16_swap(u, u, false, false); const float t = __builtin_bit_cast(float, (unsigned)r[0]) + __builtin_bit_cast(float, (unsigned)r[1]); const unsigned v = __builtin_bit_cast(unsigned, t);
    const auto s = __builtin_amdgcn_permlane32_swap(v, v, false, false); return __builtin_bit_cast(float, (unsigned)s[0]) + __builtin_bit_cast(float, (unsigned)s[1]); }
__device__ __forceinline__ float bperm_xor32(float v, int lane) { return __builtin_bit_cast(float, __builtin_amdgcn_ds_bpermute((lane ^ 32) << 2, __builtin_bit_cast(int, v))); }
__device__ __forceinline__ float fexp(float x) { return __builtin_amdgcn_exp2f(x * LOG2E); }
__device__ __forceinline__ float frcp(float x) { return __builtin_amdgcn_rcpf(x); }
__device__ __forceinline__ float fsilu(float x) { return x * frcp(1.0f + fexp(-x)); }
__device__ __forceinline__ float fsigmoid(float x) { return frcp(1.0f + fexp(-x)); }
__device__ __forceinline__ float flogsigmoid(float x) { return fminf(x, 0.f) - __builtin_amdgcn_logf(1.0f + fexp(-fabsf(x))) * LN2; }
__device__ __forceinline__ float row_sum16(float v) {
    v += __builtin_bit_cast(float, __builtin_amdgcn_update_dpp(0, __builtin_bit_cast(int, v), 0xB1, 0xF, 0xF, true));
    v += __builtin_bit_cast(float, __builtin_amdgcn_update_dpp(0, __builtin_bit_cast(int, v), 0x4E, 0xF, 0xF, true));
    v += __builtin_bit_cast(float, __builtin_amdgcn_update_dpp(0, __builtin_bit_cast(int, v), 0x141, 0xF, 0xF, true));
    v += __builtin_bit_cast(float, __builtin_amdgcn_update_dpp(0, __builtin_bit_cast(int, v), 0x140, 0xF, 0xF, true));
    return v;
}
__device__ __forceinline__ float wave_sum(float v) {
    v = row_sum16(v); const int x = __builtin_bit_cast(int, v);
    return (__builtin_bit_cast(float, __builtin_amdgcn_readlane(x, 0)) + __builtin_bit_cast(float, __builtin_amdgcn_readlane(x, 16))) +
           (__builtin_bit_cast(float, __builtin_amdgcn_readlane(x, 32)) + __builtin_bit_cast(float, __builtin_amdgcn_readlane(x, 48)));
}
__device__ __forceinline__ void unpack8(const v4u w, float (&o)[8]) { o[0] = bflo(w.x); o[1] = bfhi(w.x); o[2] = bflo(w.y); o[3] = bfhi(w.y); o[4] = bflo(w.z); o[5] = bfhi(w.z); o[6] = bflo(w.w); o[7] = bfhi(w.w); }
__device__ __forceinline__ v4u pack8(const float (&o)[8]) { v4u w; w.x = pk2(o[0], o[1]); w.y = pk2(o[2], o[3]); w.z = pk2(o[4], o[5]); w.w = pk2(o[6], o[7]); return w; }

__device__ __forceinline__ unsigned pk4_fp8(float a, float b, float c, float d) {
    a = __builtin_amdgcn_fmed3f(a, -448.f, 448.f); b = __builtin_amdgcn_fmed3f(b, -448.f, 448.f); c = __builtin_amdgcn_fmed3f(c, -448.f, 448.f); d = __builtin_amdgcn_fmed3f(d, -448.f, 448.f);
    int w = 0; w = __builtin_amdgcn_cvt_pk_fp8_f32(a, b, w, false); w = __builtin_amdgcn_cvt_pk_fp8_f32(c, d, w, true); return (unsigned)w; }
constexpr float W8_SCALE = 32.0f;

__device__ __forceinline__ void transpose_item(const float* W, int ldw, int coff, int K, bf16* WT, int mode, int row_off, LAS float* scr, int kb, int nb, int lane) {
    const int k0 = 64 * kb, n0 = 32 * nb;
    float tv[32];
#pragma unroll
    for (int i = 0; i < 32; ++i) tv[i] = __builtin_nontemporal_load(W + (size_t)(k0 + 2 * i + (lane >> 5)) * ldw + coff + n0 + (lane & 31));
#pragma unroll
    for (int i = 0; i < 32; ++i) scr[(2 * i + (lane >> 5)) * 33 + (lane & 31)] = tv[i];
    LDS_WAIT(); asm volatile("" ::: "memory");
    const int c = lane & 7;
#pragma unroll
    for (int j = 0; j < 4; ++j) { const int n = (lane >> 3) + 8 * j; const LAS float* s = scr + (8 * c) * 33 + n;
        v4u o; o.x = pk2(s[0 * 33], s[1 * 33]); o.y = pk2(s[2 * 33], s[3 * 33]); o.z = pk2(s[4 * 33], s[5 * 33]); o.w = pk2(s[6 * 33], s[7 * 33]);
        const int nn = n0 + n;
        if (mode == 3 || mode == 5) {
            v2u o8; o8.x = pk4_fp8(s[0 * 33] * W8_SCALE, s[1 * 33] * W8_SCALE, s[2 * 33] * W8_SCALE, s[3 * 33] * W8_SCALE); o8.y = pk4_fp8(s[4 * 33] * W8_SCALE, s[5 * 33] * W8_SCALE, s[6 * 33] * W8_SCALE, s[7 * 33] * W8_SCALE);
            int nr_ = nn; if (mode == 5 && nn >= 2048) { const int dm_ = nn & 63; nr_ = (nn & ~63) + 16 * (2 * (dm_ >> 5) + ((dm_ >> 2) & 1)) + 4 * ((dm_ >> 3) & 3) + (dm_ & 3); }
            *(v2u*)((unsigned char*)WT + (size_t)(row_off + nr_) * K + k0 + 8 * c) = o8;
        } else {
        const int drow = (mode == 0) ? (row_off + nn) : (mode == 4) ? (row_off + (((nn & 511) >> 7) << 8) + (nn & 127) + ((nn >> 9) << 7))
                                                       : (((nn >> 7) << 8) + (nn & 127) + (mode == 2 ? 128 : 0));
        *(v4u*)(WT + (size_t)drow * K + k0 + 8 * c) = o; } }
    LDS_WAIT(); asm volatile("" ::: "memory");
}

__device__ __forceinline__ void convert_moe(Frame& F, int layer) {
    const int tid = F.tid, w = F.wave, lane = F.lane;
    unsigned char* W13 = F.ws + WS_W13; unsigned char* W2 = F.ws + WS_W2;
    const float* m_w1 = INF(I_MW1); const float* m_w3 = INF(I_MW3); const float* m_w2 = INF(I_MW2);
    LAS unsigned* TL = (LAS unsigned*)(F.lds + 0);
    for (int it = blockIdx.x; it < NEXP * 48; it += F.G) {
        const int e = it / 48, r = it % 48, which = r >> 4, q = r & 15;
        const size_t eoff = (size_t)(layer * NEXP + e) * (1024 * 512);
        const float* src; int ldw, k0, n0; int mode;
        if (which == 0)      { src = m_w1 + eoff; ldw = 512; k0 = 64 * q; n0 = 0; mode = 1; }
        else if (which == 1) { src = m_w3 + eoff; ldw = 512; k0 = 64 * q; n0 = 0; mode = 2; }
        else                 { src = m_w2 + eoff; ldw = 1024; k0 = 64 * (q >> 1); n0 = 512 * (q & 1); mode = 0; }
        float va[4][8], vb[4][8];
#pragma unroll
        for (int pp = 0; pp < 4; ++pp) { const float* r0 = src + (size_t)(k0 + 2 * (4 * w + pp)) * ldw + n0 + lane;
#pragma unroll
            for (int m = 0; m < 8; ++m) { va[pp][m] = __builtin_nontemporal_load(r0 + 64 * m); vb[pp][m] = __builtin_nontemporal_load(r0 + ldw + 64 * m); } }
        __syncthreads();
#pragma unroll
        for (int qd = 0; qd < 2; ++qd)
#pragma unroll
            for (int m = 0; m < 8; ++m) TL[(lane + 64 * m) * 18 + 2 * w + qd] = pk4_fp8(va[2 * qd][m] * W8_SCALE, vb[2 * qd][m] * W8_SCALE, va[2 * qd + 1][m] * W8_SCALE, vb[2 * qd + 1][m] * W8_SCALE);
        __syncthreads();
#pragma unroll
        for (int i = 0; i < 4; ++i) { const int id = tid + NTHR * i, n = id >> 2, q4 = id & 3;
            const v2u lo = *(const LAS v2u*)(TL + n * 18 + 4 * q4), hi = *(const LAS v2u*)(TL + n * 18 + 4 * q4 + 2);
            if (mode == 0) { const int cc_ = n0 + n, cl_ = cc_ & 255;
                const int r_ = (cc_ & ~255) + 128 * ((cl_ >> 3) & 1) + 32 * (cl_ >> 6) + 8 * ((cl_ >> 4) & 3) + (cl_ & 7);
                *(v4u*)(W2 + (size_t)e * 1024 * 512 + (size_t)r_ * 512 + k0 + 16 * q4) = (v4u){lo.x, lo.y, hi.x, hi.y}; }
            else { const int drow = ((n >> 7) << 8) + (n & 127) + (mode == 2 ? 128 : 0);
                *(v4u*)(W13 + (size_t)e * 1024 * 1024 + (size_t)drow * 1024 + k0 + 16 * q4) = (v4u){lo.x, lo.y, hi.x, hi.y}; } }
    }
    __syncthreads();
}

__device__ __forceinline__ void phase_prologue(Frame& F) {
    LAS float* scr = (LAS float*)(F.lds + F.wave * 16384);
    const int gw = blockIdx.x * NWAVES + F.wave, NGW = F.G * NWAVES;
    const int gt = blockIdx.x * NTHR + F.tid, NGT = F.G * NTHR;
    const float* e_win = INF(I_EWIN);
    {
        const float* e_wout = INF(I_EWOUT); const float* o_wqkv = INF(I_OWQKV); const float* o_wout = INF(I_OWOUT); const float* e_wg2 = INF(I_EWG2);
        bf16* WIN = (bf16*)(F.ws + WS_WIN); bf16* WOE = (bf16*)(F.ws + WS_WOE); bf16* WQKV = (bf16*)(F.ws + WS_WQKV); bf16* WOO = (bf16*)(F.ws + WS_WOO);
        constexpr int I_A = 16 * 48, I_U = 16 * 32, I_O = 16 * 32, I_Q = 16 * 96, PER = I_A + I_U + I_O + I_Q + I_O;
        for (int it = gw; it < 2 * PER; it += NGW) {
            const int i = it / PER; int r = it % PER;
            if (r < I_A) { transpose_item(e_win + (size_t)i * 1024 * 2576, 2576, 0, 1024, WIN + (size_t)i * ZEW * 1024, 0, 0, scr, r / 48, r % 48, F.lane); continue; } r -= I_A;
            if (r < I_U) { transpose_item(e_win + (size_t)i * 1024 * 2576, 2576, 1552, 1024, WIN + (size_t)i * ZEW * 1024, 4, 1792, scr, r / 32, r % 32, F.lane); continue; } r -= I_U;
            if (r < I_O) { transpose_item(e_wout + (size_t)i * 1024 * 1024, 1024, 0, 1024, WOE + (size_t)i * 1024 * 1024, 0, 0, scr, r / 32, r % 32, F.lane); continue; } r -= I_O;
            if (r < I_Q) { transpose_item(o_wqkv + (size_t)i * 1024 * 3072, 3072, 0, 1024, (bf16*)((unsigned char*)WQKV + (size_t)i * 3072 * 1024), 5, 0, scr, r / 96, r % 96, F.lane); continue; } r -= I_Q;
            transpose_item(o_wout + (size_t)i * 1024 * 1024, 1024, 0, 1024, (bf16*)((unsigned char*)WOO + (size_t)i * 1024 * 1024), 3, 0, scr, r / 32, r % 32, F.lane);
        }
        for (int it = gt; it < 2 * 256 * 128; it += NGT) {
            const int i = it >> 15, c = (it >> 7) & 255, kg = it & 127;
            const float* win = e_win + (size_t)i * 1024 * 2576 + 1536; const float* wg = e_wg2 + (size_t)i * 16 * 256 + c;
            float g[16];
#pragma unroll
            for (int r = 0; r < 16; ++r) g[r] = wg[r * 256];
            float o[8];
#pragma unroll
            for (int kk = 0; kk < 8; ++kk) { const float* wr = win + (size_t)(kg * 8 + kk) * 2576; float s = 0.f;
#pragma unroll
                for (int r = 0; r < 16; ++r) s += wr[r] * g[r];
                o[kk] = s; }
            v4u w; w.x = pk2(o[0], o[1]); w.y = pk2(o[2], o[3]); w.z = pk2(o[4], o[5]); w.w = pk2(o[6], o[7]);
            *(v4u*)(WIN + (size_t)i * ZEW * 1024 + (size_t)(1536 + c) * 1024 + kg * 8) = w;
        }
    }
    {
        bf16* WR = (bf16*)(F.ws + WS_WRT); const float* m_wgrp = INF(I_MWGRP); const float* m_wrt = INF(I_MWRT);
        for (int it = gt; it < DEPTH * 48 * 128; it += NGT) {
            const int l = it / (48 * 128), r = it % (48 * 128), o = r >> 7, kg = r & 127;
            float v[8], lo[8];
#pragma unroll
            for (int kk = 0; kk < 8; ++kk) { const int k = kg * 8 + kk;
                v[kk] = (o < 4) ? m_wgrp[((size_t)l * 1024 + k) * 4 + o] : ((o < 36) ? m_wrt[((size_t)l * 1024 + k) * 32 + (o - 4)] : 0.f);
                lo[kk] = v[kk] - bf2f(f2bf(v[kk])); }
            *(v4u*)(WR + ((size_t)(l * 2 + 0) * 48 + o) * 1024 + kg * 8) = pack8(v);
            *(v4u*)(WR + ((size_t)(l * 2 + 1) * 48 + o) * 1024 + kg * 8) = pack8(lo);
        }
    }
    {
        float* CS = (float*)(F.ws + WS_CS); const int* pos = (const int*)inptr_raw(I_POS);
        for (int it = gt; it < T * 8; it += NGT) {
            const int t = it >> 3, i = it & 7;
            const double revs[8] = {0.15915494309189535, 0.03086376340470123, 0.005985185712713705, 0.001160663641240061, 0.00022507907903927653, 4.364795279280289e-05, 8.464330808241401e-06, 1.6414262627950345e-06};
            double rv = 0.0;
#pragma unroll
            for (int q = 0; q < 8; ++q) rv = (i == q) ? revs[q] : rv;
            const double a = (double)pos[t] * rv; const float fr = (float)(a - __builtin_rint(a));
            CS[(size_t)t * 16 + i] = __builtin_amdgcn_cosf(fr); CS[(size_t)t * 16 + 8 + i] = __builtin_amdgcn_sinf(fr);
        }
    }
    {
        float* MOD = (float*)(F.ws + WS_MOD); const float* cin = INF(I_C); const float* ada_w = INF(I_ADAW); const float* ada_b = INF(I_ADAB);
        LAS float* cond = (LAS float*)(F.lds + 0);
        LAS float* red = (LAS float*)(F.lds + 32768);
        __syncthreads();
        for (int i = F.tid; i < NB * 1024; i += NTHR) { const float v = cin[i]; cond[i] = v / (1.0f + expf(-v)); }
        __syncthreads();
        for (int it = blockIdx.x; it < DEPTH * 48; it += F.G) {
            const int l = it / 48, j0 = (it % 48) * 128;
            const float* W = ada_w + (size_t)l * 1024 * 6144 + j0 + 2 * F.lane;
            float a0[8], a1[8];
#pragma unroll
            for (int b = 0; b < 8; ++b) { a0[b] = 0.f; a1[b] = 0.f; }
            for (int kc = 0; kc < 8; ++kc) { const int kb = F.wave * 128 + kc * 16;
                f32x2 wv[16];
#pragma unroll
                for (int kk = 0; kk < 16; ++kk) wv[kk] = __builtin_nontemporal_load((const f32x2*)(W + (size_t)(kb + kk) * 6144));
#pragma unroll
                for (int kk = 0; kk < 16; ++kk)
#pragma unroll
                    for (int b = 0; b < 8; ++b) { const float cv = cond[b * 1024 + kb + kk]; a0[b] += cv * wv[kk].x; a1[b] += cv * wv[kk].y; }
            }
#pragma unroll
            for (int b = 0; b < 8; ++b) { red[(F.wave * 8 + b) * 128 + 2 * F.lane] = a0[b]; red[(F.wave * 8 + b) * 128 + 2 * F.lane + 1] = a1[b]; }
            __syncthreads();
            for (int o = F.tid; o < 8 * 128; o += NTHR) { const int b = o >> 7, j = o & 127; float s = 0.f;
#pragma unroll
                for (int w = 0; w < 8; ++w) s += red[(w * 8 + b) * 128 + j];
                MOD[((size_t)l * 8 + b) * 6144 + j0 + j] = s + ada_b[l * 6144 + j0 + j]; }
            __syncthreads();
        }
    }
}

__device__ __forceinline__ void build_tstart(Frame& F, int layer) {
    LAS int* ts = (LAS int*)(F.lds + LDS_TAB);
    __syncthreads();
    if (F.wave == 0) {
        const int lane = F.lane;
        const unsigned cn = (lane < NEXP) ? __hip_atomic_load(F.ctl + CW_CNT + layer * 32 + lane, RLX_AGENT) : 0u;
        const int tl = (int)((cn + 255u) >> 8);
        int v = tl;
        v += __builtin_amdgcn_update_dpp(0, v, 0x111, 0xF, 0xF, true);
        v += __builtin_amdgcn_update_dpp(0, v, 0x112, 0xF, 0xF, true);
        v += __builtin_amdgcn_update_dpp(0, v, 0x114, 0xF, 0xF, true);
        v += __builtin_amdgcn_update_dpp(0, v, 0x118, 0xF, 0xF, true);
        const int t0 = __builtin_amdgcn_readlane(v, 15);
        if (lane >= 16) v += t0;
        if (lane < NEXP) ts[lane] = v - tl;
        if (lane == NEXP - 1) ts[NEXP] = v; }
    __syncthreads();
}

__device__ __forceinline__ void phase_n1(Frame& F, int layer, const float probe_scale = 1.0f) {
    const int gw = blockIdx.x * NWAVES + F.wave; const int b = gw >> 8; const int lane = F.lane;
    const float* MOD = (const float*)(F.ws + WS_MOD);
    const bool fin = (layer == DEPTH);
    const float* fng = INF(I_FNG); const float* n1g = INF(I_N1G); const float* xin0 = INF(I_X);
    f32x4 A[4], Bv[4], G2[4];
#pragma unroll
    for (int j = 0; j < 4; ++j) { const int c = 256 * j + 4 * lane;
        if (fin) { A[j] = *(const f32x4*)(fng + c); Bv[j] = (f32x4){0.f, 0.f, 0.f, 0.f}; }
        else { const float* m = MOD + ((size_t)layer * 8 + b) * 6144; const f32x4 g = *(const f32x4*)(n1g + layer * 1024 + c), sc = *(const f32x4*)(m + 1024 + c);
            A[j] = g * (sc + 1.0f); Bv[j] = *(const f32x4*)(m + c); }
        G2[j] = (f32x4){0.f, 0.f, 0.f, 0.f};
        if (layer > 0) G2[j] = *(const f32x4*)(MOD + ((size_t)(layer - 1) * 8 + b) * 6144 + 5120 + c) * (probe_scale * 0.0625f); }
    const float* TW = (const float*)(F.ws + WS_TOKW);
    const unsigned char* YS8 = F.ws + WS_YS; bf16* H = (bf16*)(F.ws + WS_H); unsigned char* XH = F.ws + WS_XH;
    int dl = 0; float wl = 0.f;
    if (layer > 0) { build_tstart(F, layer - 1);
        const int* TE = (const int*)(F.ws + WS_TOKE); const int* TR = (const int*)(F.ws + WS_TOKR);
        dl = ((const LAS int*)(F.lds + LDS_TAB))[TE[(size_t)gw * 64 + lane]] * 256 + TR[(size_t)gw * 64 + lane]; wl = TW[(size_t)gw * 64 + lane]; }
    for (int r = 0; r < 32; r += 2) {
        f32x4 v[2][4]; unsigned y0[2][4], y1[2][4]; float w0[2], w1[2];
#pragma unroll
        for (int p = 0; p < 2; ++p) { const size_t t = (size_t)gw * 32 + r + p;
            if (layer == 0) {
#pragma unroll
                for (int j = 0; j < 4; ++j) v[p][j] = *(const f32x4*)(xin0 + t * D + 256 * j + 4 * lane);
            } else {
                const int d0 = __builtin_amdgcn_readlane(dl, 2 * (r + p)), d1 = __builtin_amdgcn_readlane(dl, 2 * (r + p) + 1); w0[p] = __builtin_bit_cast(float, __builtin_amdgcn_readlane(__builtin_bit_cast(int, wl), 2 * (r + p))); w1[p] = __builtin_bit_cast(float, __builtin_amdgcn_readlane(__builtin_bit_cast(int, wl), 2 * (r + p) + 1));
#pragma unroll
                for (int j = 0; j < 4; ++j) { const int c = 256 * j + 4 * lane;
                    v[p][j] = ldxh(XH, t, c); y0[p][j] = __builtin_nontemporal_load((const unsigned*)(YS8 + (size_t)d0 * D + c)); y1[p][j] = __builtin_nontemporal_load((const unsigned*)(YS8 + (size_t)d1 * D + c)); }
            } }
#pragma unroll
        for (int p = 0; p < 2; ++p) { const size_t t = (size_t)gw * 32 + r + p;
            if (layer > 0) {
#pragma unroll
                for (int j = 0; j < 4; ++j) { f32x4 y;
                    typedef float f32x2_ __attribute__((ext_vector_type(2)));
                    const f32x2_ a0 = __builtin_amdgcn_cvt_pk_f32_fp8((int)y0[p][j], false), a1 = __builtin_amdgcn_cvt_pk_f32_fp8((int)y0[p][j], true), b0 = __builtin_amdgcn_cvt_pk_f32_fp8((int)y1[p][j], false), b1 = __builtin_amdgcn_cvt_pk_f32_fp8((int)y1[p][j], true);
                    y.x = w0[p] * a0.x + w1[p] * b0.x; y.y = w0[p] * a0.y + w1[p] * b0.y; y.z = w0[p] * a1.x + w1[p] * b1.x; y.w = w0[p] * a1.y + w1[p] * b1.y;
                    v[p][j] = v[p][j] + G2[j] * y; }
                if (!fin) {
#pragma unroll
                    for (int j = 0; j < 4; ++j) stxh(XH, t, 256 * j + 4 * lane, v[p][j]);
                }
            }
            float ss = 0.f;
#pragma unroll
            for (int j = 0; j < 4; ++j) ss += (v[p][j].x * v[p][j].x + v[p][j].y * v[p][j].y) + (v[p][j].z * v[p][j].z + v[p][j].w * v[p][j].w);
            const float rstd = __builtin_amdgcn_rsqf(wave_sum(ss) * (1.0f / D) + NORM_EPS);
            if (fin) {
#pragma unroll
                for (int j = 0; j < 4; ++j) __builtin_nontemporal_store(v[p][j] * rstd * A[j], (f32x4*)(F.out + t * D + 256 * j + 4 * lane));
            } else {
#pragma unroll
                for (int j = 0; j < 4; ++j) { const f32x4 hh = v[p][j] * rstd * A[j] + Bv[j];
                    if (layer & 1) *(unsigned*)((unsigned char*)H + t * D + 256 * j + 4 * lane) = pk4_fp8(hh.x, hh.y, hh.z, hh.w);
                    else { v2u o; o.x = pk2(hh.x, hh.y); o.y = pk2(hh.z, hh.w); *(v2u*)(H + t * D + 256 * j + 4 * lane) = o; } }
            }
        }
    }
}

constexpr int N2_HH = 0, N2_HL = 66048, N2_PART = 0  , N2_LG = 132096, N2_LE = 138240, N2_LR = 140288, N2_LCNT = 142336, N2_LBASE = 142464;
__device__ __forceinline__ void phase_n2(Frame& F, int layer, const bool probe_dry = false) {
    const int gw = blockIdx.x * NWAVES + F.wave; const int b = gw >> 8; const int lane = F.lane, w = F.wave, tid = F.tid, c = lane & 15, g = lane >> 4;
    const float* MOD = (const float*)(F.ws + WS_MOD) + ((size_t)layer * 8 + b) * 6144;
    LAS float* part = (LAS float*)(F.lds + N2_PART);
    LAS float* lg = (LAS float*)(F.lds + N2_LG);
    LAS int* le = (LAS int*)(F.lds + N2_LE);
    LAS int* lr = (LAS int*)(F.lds + N2_LR);
    LAS int* lcnt = (LAS int*)(F.lds + N2_LCNT);
    LAS int* lbase = (LAS int*)(F.lds + N2_LBASE);
    __syncthreads();
    if (tid < 32) lcnt[tid] = 0;
    const float* n2g = INF(I_N2G); const float* m_bgrp = INF(I_MBGRP); const float* m_brt = INF(I_MBRT);
    f32x4 A[4], Bv[4], G1[4];
#pragma unroll
    for (int j = 0; j < 4; ++j) { const int cc = 256 * j + 4 * lane;
        const f32x4 gg = *(const f32x4*)(n2g + layer * 1024 + cc), sc = *(const f32x4*)(MOD + 4096 + cc);
        A[j] = gg * (sc + 1.0f); Bv[j] = *(const f32x4*)(MOD + 3072 + cc); G1[j] = *(const f32x4*)(MOD + 2048 + cc) * (probe_dry ? 0.0f : 1.0f); }
    bf16x8 wh[4][3], wl[4][3];
    { const bf16* WRH = (const bf16*)(F.ws + WS_WRT) + (size_t)layer * 2 * 48 * 1024; const bf16* WRL = WRH + 48 * 1024;
#pragma unroll
        for (int s = 0; s < 4; ++s)
#pragma unroll
            for (int nt = 0; nt < 3; ++nt) { const size_t o = (size_t)(16 * nt + c) * 1024 + 128 * w + 32 * s + 8 * g;
                wh[s][nt] = *(const bf16x8*)(WRH + o); wl[s][nt] = *(const bf16x8*)(WRL + o); } }
    const float* xin = INF(I_X); unsigned char* XH = F.ws + WS_XH;
    const bf16* Y = (const bf16*)(F.ws + WS_H); bf16* H = (bf16*)(F.ws + WS_H);
    float* TW = (float*)(F.ws + WS_TOKW); unsigned char* H8 = F.ws + WS_H8;
    for (int rg = 0; rg < 8; ++rg) {
        {
        v2u xr[4][4], yv[4][4];
#pragma unroll
        for (int q2 = 0; q2 < 4; ++q2) { const size_t t = (size_t)gw * 32 + rg * 4 + q2;
#pragma unroll
            for (int j = 0; j < 4; ++j) { const int cc = 256 * j + 4 * lane;
                xr[q2][j] = (layer == 0) ? __builtin_bit_cast(v2u, __builtin_convertvector(__builtin_nontemporal_load((const f32x4*)(xin + t * D + cc)), h16x4)) : __builtin_nontemporal_load((const v2u*)(XH + (t * D + cc) * 2));
                yv[q2][j] = *(const v2u*)(Y + t * D + cc); } }
#pragma unroll
        for (int q2 = 0; q2 < 4; ++q2) {
            const int q = q2;
            const size_t t = (size_t)gw * 32 + rg * 4 + q;
            f32x4 v[4]; float ss = 0.f;
#pragma unroll
            for (int j = 0; j < 4; ++j) { const int cc = 256 * j + 4 * lane;
                f32x4 y; y.x = bflo(yv[q2][j].x); y.y = bfhi(yv[q2][j].x); y.z = bflo(yv[q2][j].y); y.w = bfhi(yv[q2][j].y);
                v[j] = __builtin_convertvector(__builtin_bit_cast(h16x4, xr[q2][j]), f32x4) + G1[j] * y;
                stxh(XH, t, cc, v[j]);
                ss += (v[j].x * v[j].x + v[j].y * v[j].y) + (v[j].z * v[j].z + v[j].w * v[j].w); }
            const float rstd = __builtin_amdgcn_rsqf(wave_sum(ss) * (1.0f / D) + NORM_EPS);
#pragma unroll
            for (int j = 0; j < 4; ++j) { const f32x4 hv = v[j] * rstd * A[j] + Bv[j];
                v2u hi; hi.x = pk2(hv.x, hv.y); hi.y = pk2(hv.z, hv.w);
                if (!probe_dry) *(unsigned*)(H8 + t * D + 256 * j + 4 * lane) = pk4_fp8(hv.x, hv.y, hv.z, hv.w);
                v2u lo; lo.x = pk2(hv.x - bflo(hi.x), hv.y - bfhi(hi.x)); lo.y = pk2(hv.z - bflo(hi.y), hv.w - bfhi(hi.y));
                *(LAS v2u*)(F.lds + N2_HH + (w * 4 + q) * 2064 + (256 * j + 4 * lane) * 2) = hi;
                *(LAS v2u*)(F.lds + N2_HL + (w * 4 + q) * 2064 + (256 * j + 4 * lane) * 2) = lo; }
        }
        }
        __syncthreads();
        f32x4 acc[2][3];
#pragma unroll
        for (int rt = 0; rt < 2; ++rt)
#pragma unroll
            for (int nt = 0; nt < 3; ++nt) acc[rt][nt] = (f32x4){0.f, 0.f, 0.f, 0.f};
#pragma unroll
        for (int s = 0; s < 4; ++s)
#pragma unroll
            for (int rt = 0; rt < 2; ++rt) { const int off = (16 * rt + c) * 2064 + (128 * w + 32 * s + 8 * g) * 2;
                const bf16x8 ah = *(const LAS bf16x8*)(F.lds + N2_HH + off), al = *(const LAS bf16x8*)(F.lds + N2_HL + off);
#pragma unroll
                for (int nt = 0; nt < 3; ++nt) { f32x4 a = acc[rt][nt];
                    a = __builtin_amdgcn_mfma_f32_16x16x32_bf16(ah, wh[s][nt], a, 0, 0, 0); a = __builtin_amdgcn_mfma_f32_16x16x32_bf16(ah, wl[s][nt], a, 0, 0, 0);
                    a = __builtin_amdgcn_mfma_f32_16x16x32_bf16(al, wh[s][nt], a, 0, 0, 0); acc[rt][nt] = a; } }
        __syncthreads();
#pragma unroll
        for (int rt = 0; rt < 2; ++rt)
#pragma unroll
            for (int nt = 0; nt < 3; ++nt)
#pragma unroll
                for (int r = 0; r < 4; ++r) part[(w * 32 + 16 * rt + 4 * g + r) * 48 + 16 * nt + c] = acc[rt][nt][r];
        __syncthreads();
#pragma unroll
        for (int i3 = 0; i3 < 3; ++i3) { const int id = tid + NTHR * i3; float s = 0.f;
#pragma unroll
            for (int ww = 0; ww < 8; ++ww) s += part[ww * 1536 + id];
            lg[id] = s; }
        __syncthreads();
        if (tid < 32) {
            const LAS float* L = lg + tid * 48;
            const float* bg = m_bgrp + layer * 4; const float* br = m_brt + layer * 32;
            float gl[4];
#pragma unroll
            for (int i = 0; i < 4; ++i) gl[i] = L[i] + bg[i];
            int gi = 0; float gm = gl[0];
#pragma unroll
            for (int i = 1; i < 4; ++i) if (gl[i] > gm) { gm = gl[i]; gi = i; }
            float gs = 0.f;
#pragma unroll
            for (int i = 0; i < 4; ++i) gs += expf(gl[i] - gm);
            const float gwt = 1.0f / gs;
            float ev[8];
#pragma unroll
            for (int i = 0; i < 8; ++i) ev[i] = L[4 + gi * 8 + i] + br[gi * 8 + i];
            int i1 = 0; float v1 = ev[0];
#pragma unroll
            for (int i = 1; i < 8; ++i) if (ev[i] > v1) { v1 = ev[i]; i1 = i; }
            int i2 = (i1 == 0) ? 1 : 0; float v2 = -3.0e38f;
#pragma unroll
            for (int i = 0; i < 8; ++i) if (i != i1 && ev[i] > v2) { v2 = ev[i]; i2 = i; }
            const float ex = expf(v2 - v1); const float w1 = 1.0f / (1.0f + ex), w2 = ex * w1;
            const int e0 = gi * 8 + i1, e1 = gi * 8 + i2;
            const int lrow = (tid >> 2) * 32 + rg * 4 + (tid & 3);
            le[2 * lrow] = e0; le[2 * lrow + 1] = e1;
            lr[2 * lrow] = __hip_atomic_fetch_add(&lcnt[e0], 1, __ATOMIC_RELAXED, __HIP_MEMORY_SCOPE_WORKGROUP); lr[2 * lrow + 1] = __hip_atomic_fetch_add(&lcnt[e1], 1, __ATOMIC_RELAXED, __HIP_MEMORY_SCOPE_WORKGROUP);
            const size_t t = (size_t)(blockIdx.x * NWAVES + (tid >> 2)) * 32 + rg * 4 + (tid & 3);
            TW[2 * t] = w1 * gwt; TW[2 * t + 1] = w2 * gwt;
        }
    }
    __syncthreads();
    if (probe_dry) return;
    if (tid < 32) lbase[tid] = (int)atomicAdd((unsigned*)(F.ctl + CW_CNT + layer * 32 + tid), (unsigned)lcnt[tid]);
    __syncthreads();
    {
        int* TE = (int*)(F.ws + WS_TOKE); int* TR = (int*)(F.ws + WS_TOKR);
        const int a = tid;
        const int lrow = a >> 1; const size_t t = (size_t)(blockIdx.x * NWAVES + (lrow >> 5)) * 32 + (lrow & 31);
        const int e = le[a];
        const int rank = lbase[e] + lr[a];
        TE[2 * t + (a & 1)] = e; TR[2 * t + (a & 1)] = rank;
        ((int*)(F.ws + WS_EXPTOK))[(size_t)e * CAPE + rank] = (int)t;
    }
}

__device__ __forceinline__ s16x4 vtr(const LAS unsigned char* p) { return __builtin_bit_cast(s16x4, __builtin_amdgcn_ds_read_tr16_b64_v4i16((LAS v4i16_t*)p)); }
constexpr int GL_LA = 0, GL_TOT = 16640, GL_QT = 18688, GL_KT = 28928, GL_VT = 39168, GL_ST = 57600, GL_SSQ = 76032;
struct GlaRaw { v4u k, gp, q; v4u v[2]; v4u s[2]; };
template <bool OUT> __device__ __forceinline__ void gla_load(Frame& F, const bf16* Z, const bf16* KV, int u, size_t t0, int h, GlaRaw& R) {
    const int tid = F.tid, j = F.lane, w = F.wave;
    const bf16* zr = Z + (t0 + j) * ZE;
    R.k = *(const v4u*)(zr + 256 + h * 64 + 8 * w); R.gp = *(const v4u*)(zr + 1536 + h * 64 + 8 * w);
    R.q = (v4u){0u, 0u, 0u, 0u}; if (OUT) R.q = *(const v4u*)(zr + h * 64 + 8 * w);
#pragma unroll
    for (int i2 = 0; i2 < 2; ++i2) { const int id = tid + NTHR * i2, jj = id >> 4, c16 = id & 15; R.v[i2] = *(const v4u*)(Z + (t0 + jj) * ZE + 512 + h * 128 + 8 * c16); }
    if (OUT) {
#pragma unroll
        for (int i2 = 0; i2 < 2; ++i2) { const int id = tid + NTHR * i2, row = id >> 4, c16 = id & 15; R.s[i2] = *(const v4u*)(KV + (size_t)u * 8192 + row * 128 + 8 * c16); }
    }
}
__device__ __forceinline__ float lane_scan(float v, int lane) {
    v += __builtin_bit_cast(float, __builtin_amdgcn_update_dpp(0, __builtin_bit_cast(int, v), 0x111, 0xF, 0xF, true));
    v += __builtin_bit_cast(float, __builtin_amdgcn_update_dpp(0, __builtin_bit_cast(int, v), 0x112, 0xF, 0xF, true));
    v += __builtin_bit_cast(float, __builtin_amdgcn_update_dpp(0, __builtin_bit_cast(int, v), 0x114, 0xF, 0xF, true));
    v += __builtin_bit_cast(float, __builtin_amdgcn_update_dpp(0, __builtin_bit_cast(int, v), 0x118, 0xF, 0xF, true));
    const int x = __builtin_bit_cast(int, v);
    const float t0 = __builtin_bit_cast(float, __builtin_amdgcn_readlane(x, 15)), t1 = __builtin_bit_cast(float, __builtin_amdgcn_readlane(x, 31)), t2 = __builtin_bit_cast(float, __builtin_amdgcn_readlane(x, 47));
    const int r = lane >> 4;
    return v + ((r >= 1) ? t0 : 0.f) + ((r >= 2) ? t1 : 0.f) + ((r >= 3) ? t2 : 0.f);
}
template <bool OUT> __device__ __forceinline__ void gla_prep(Frame& F, const GlaRaw& R, const float* bgate, float* decp) {
    const int tid = F.tid, j = F.lane, w = F.wave;
#pragma unroll
    for (int i2 = 0; i2 < 2; ++i2) { const int id = tid + NTHR * i2, jj = id >> 4, c16 = id & 15; *(LAS v4u*)(F.lds + GL_VT + jj * 288 + c16 * 16) = R.v[i2]; }
    if (OUT) {
#pragma unroll
        for (int i2 = 0; i2 < 2; ++i2) { const int id = tid + NTHR * i2, row = id >> 4, c16 = id & 15; *(LAS v4u*)(F.lds + GL_ST + row * 288 + c16 * 16) = R.s[i2]; }
    }
    const f32x4 bg0 = *(const f32x4*)(bgate + 8 * w), bg1 = *(const f32x4*)(bgate + 8 * w + 4);
    const float bias[8] = {bg0.x, bg0.y, bg0.z, bg0.w, bg1.x, bg1.y, bg1.z, bg1.w};
    float gp[8], kv[8], qv[8]; unpack8(R.gp, gp); unpack8(R.k, kv); unpack8(R.q, qv);
    float ko[8], qo[8];
#pragma unroll
    for (int e = 0; e < 8; ++e) { const float b = lane_scan(flogsigmoid(gp[e] + bias[e]) * (1.0f / 16.0f), j);
        if (OUT) { qo[e] = qv[e] * 0.125f * fexp(b); ko[e] = kv[e] * fexp(-b); }
        else { const float bl = __builtin_bit_cast(float, __builtin_amdgcn_readlane(__builtin_bit_cast(int, b), 63)); ko[e] = kv[e] * fexp(bl - b); qo[e] = fexp(bl); } }
    *(LAS v4u*)(F.lds + GL_KT + j * 160 + w * 16) = pack8(ko);
    if (OUT) *(LAS v4u*)(F.lds + GL_QT + j * 160 + w * 16) = pack8(qo);
    else if (j == 63) { *(f32x4*)(decp + 8 * w) = (f32x4){qo[0], qo[1], qo[2], qo[3]}; *(f32x4*)(decp + 8 * w + 4) = (f32x4){qo[4], qo[5], qo[6], qo[7]}; }
}
__device__ __forceinline__ bf16x8 tr2(const LAS unsigned char* p0, const LAS unsigned char* p1) {
    const s16x4 lo = vtr(p0), hi = vtr(p1); return (bf16x8){lo[0], lo[1], lo[2], lo[3], hi[0], hi[1], hi[2], hi[3]};
}
__device__ __forceinline__ void phase_gla_kv(Frame& F, int i) {
    const bf16* Z = (const bf16*)(F.ws + WS_Z); bf16* KV = (bf16*)(F.ws + WS_X1); float* DEC = (float*)(F.ws + WS_DEC);
    const float* bg = INF(I_EBG) + i * 256;
    const int w = F.wave, c = F.lane & 15, g = F.lane >> 4, kt = w & 3, vt0 = 4 * (w >> 2);
#define GLA_UNIT(k16_, b_, h_, n_, u_, t0_) const int b_ = (int)blockIdx.x >> 5, h_ = (k16_) & 3, n_ = 4 * ((int)blockIdx.x & 31) + ((k16_) >> 2), u_ = ((b_ * 4 + h_) << 7) + n_; const size_t t0_ = (size_t)b_ * SEQ + n_ * 64
    GlaRaw R;
    { GLA_UNIT(0, b0, h0, n0, u0, t00); gla_load<false>(F, Z, nullptr, u0, t00, h0, R); }
    for (int k16 = 0; k16 < 16; ++k16) {
        GLA_UNIT(k16, b, h, n, u, t0);
        __syncthreads();
        gla_prep<false>(F, R, bg + h * 64, DEC + (size_t)u * 64);
        if (k16 < 15) { GLA_UNIT(k16 + 1, b2, h2, n2, u2, t02); gla_load<false>(F, Z, nullptr, u2, t02, h2, R); }
        __syncthreads();
        f32x4 acc[4];
#pragma unroll
        for (int q4 = 0; q4 < 4; ++q4) acc[q4] = (f32x4){0.f, 0.f, 0.f, 0.f};
#pragma unroll
        for (int s = 0; s < 2; ++s) { const int row0 = 32 * s + 8 * g + (c >> 2);
            const bf16x8 A = tr2(F.lds + GL_KT + row0 * 160 + (16 * kt + 4 * (c & 3)) * 2, F.lds + GL_KT + (row0 + 4) * 160 + (16 * kt + 4 * (c & 3)) * 2);
#pragma unroll
            for (int q4 = 0; q4 < 4; ++q4) { const int vt = vt0 + q4;
                const bf16x8 Bf = tr2(F.lds + GL_VT + row0 * 288 + (16 * vt + 4 * (c & 3)) * 2, F.lds + GL_VT + (row0 + 4) * 288 + (16 * vt + 4 * (c & 3)) * 2);
                acc[q4] = __builtin_amdgcn_mfma_f32_16x16x32_bf16(Bf, A, acc[q4], 0, 0, 0); } }
#pragma unroll
        for (int q4 = 0; q4 < 4; ++q4) { v2u o; o.x = pk2(acc[q4][0], acc[q4][1]); o.y = pk2(acc[q4][2], acc[q4][3]);
            *(v2u*)(KV + ((size_t)u * 64 + 16 * kt + c) * 128 + 16 * (vt0 + q4) + 4 * g) = o; }
    }
}
__device__ __forceinline__ void phase_gla_scan(Frame& F) {
    bf16* KV = (bf16*)(F.ws + WS_X1); const float* DEC = (const float*)(F.ws + WS_DEC);
    for (int gt = blockIdx.x * NTHR + F.tid; gt < 32 * 4096; gt += F.G * NTHR) {
        const int bh = gt >> 12, e2 = gt & 4095, k = e2 >> 6;
        unsigned* p = (unsigned*)(KV + (size_t)bh * 128 * 8192 + 2 * e2); const float* dp = DEC + (size_t)bh * 128 * 64 + k;
        float s0 = 0.f, s1 = 0.f;
#pragma unroll 16
        for (int n = 0; n < 128; ++n) { const unsigned kvw = p[(size_t)n * 4096]; const float d = dp[n * 64];
            p[(size_t)n * 4096] = pk2(s0, s1); s0 = s0 * d + bflo(kvw); s1 = s1 * d + bfhi(kvw); }
    }
}
__device__ __forceinline__ void phase_gla_out(Frame& F, int i) {
    const bf16* Z = (const bf16*)(F.ws + WS_Z); const bf16* KV = (const bf16*)(F.ws + WS_X1); bf16* MIX = (bf16*)(F.ws + WS_M);
    const float* bg = INF(I_EBG) + i * 256; const float* gng = INF(I_EGNG) + i * 128;
    const int tid = F.tid, w = F.wave, c = F.lane & 15, g = F.lane >> 4, I = w & 3, vt0 = 4 * (w >> 2);
    LAS float* ssq = (LAS float*)(F.lds + GL_SSQ);
    GlaRaw R;
    { GLA_UNIT(0, b0, h0, n0, u0, t00); gla_load<true>(F, Z, KV, u0, t00, h0, R); }
    for (int k16 = 0; k16 < 16; ++k16) {
        GLA_UNIT(k16, b, h, n, u, t0);
        v4u gvr[2];
#pragma unroll
        for (int i2 = 0; i2 < 2; ++i2) { const int id = tid + NTHR * i2, jj = id >> 4, c16 = id & 15; gvr[i2] = *(const v4u*)(Z + (t0 + jj) * ZE + 1024 + h * 128 + 8 * c16); }
        __syncthreads();
        gla_prep<true>(F, R, bg + h * 64, nullptr);
        if (k16 < 15) { GLA_UNIT(k16 + 1, b2, h2, n2, u2, t02); gla_load<true>(F, Z, KV, u2, t02, h2, R); }
        __syncthreads();
        bf16x8 qf[2];
#pragma unroll
        for (int s = 0; s < 2; ++s) qf[s] = *(const LAS bf16x8*)(F.lds + GL_QT + (16 * I + c) * 160 + (32 * s + 8 * g) * 2);
        f32x4 P[4];
#pragma unroll
        for (int J = 0; J < 4; ++J) { P[J] = (f32x4){0.f, 0.f, 0.f, 0.f};
            if (J <= I) { const bf16x8 k0 = *(const LAS bf16x8*)(F.lds + GL_KT + (16 * J + c) * 160 + (8 * g) * 2), k1 = *(const LAS bf16x8*)(F.lds + GL_KT + (16 * J + c) * 160 + (32 + 8 * g) * 2);
                f32x4 z = {0.f, 0.f, 0.f, 0.f}; z = __builtin_amdgcn_mfma_f32_16x16x32_bf16(k0, qf[0], z, 0, 0, 0); z = __builtin_amdgcn_mfma_f32_16x16x32_bf16(k1, qf[1], z, 0, 0, 0);
                if (J == I) {
#pragma unroll
                    for (int r = 0; r < 4; ++r) z[r] = (4 * g + r <= c) ? z[r] : 0.f; }
                P[J] = z; } }
        bf16x8 pa[2];
#pragma unroll
        for (int p = 0; p < 2; ++p) { v4u t; t.x = pk2(P[2 * p][0], P[2 * p][1]); t.y = pk2(P[2 * p][2], P[2 * p][3]); t.z = pk2(P[2 * p + 1][0], P[2 * p + 1][1]); t.w = pk2(P[2 * p + 1][2], P[2 * p + 1][3]);
            pa[p] = __builtin_bit_cast(bf16x8, t); }
        f32x4 acc[4];
#pragma unroll
        for (int q4 = 0; q4 < 4; ++q4) { const int vt = vt0 + q4; const int cb = (16 * vt + 4 * (c & 3)) * 2;
            f32x4 a = {0.f, 0.f, 0.f, 0.f};
#pragma unroll
            for (int s = 0; s < 2; ++s) { const int row0 = 32 * s + 8 * g + (c >> 2);
                a = __builtin_amdgcn_mfma_f32_16x16x32_bf16(qf[s], tr2(F.lds + GL_ST + row0 * 288 + cb, F.lds + GL_ST + (row0 + 4) * 288 + cb), a, 0, 0, 0); }
#pragma unroll
            for (int p = 0; p < 2; ++p) if (2 * p <= I) { const int rA = 32 * p + 4 * g + (c >> 2);
                a = __builtin_amdgcn_mfma_f32_16x16x32_bf16(pa[p], tr2(F.lds + GL_VT + rA * 288 + cb, F.lds + GL_VT + (rA + 16) * 288 + cb), a, 0, 0, 0); }
            acc[q4] = a; }
#pragma unroll
        for (int r = 0; r < 4; ++r) { float s = 0.f;
#pragma unroll
            for (int q4 = 0; q4 < 4; ++q4) s += acc[q4][r] * acc[q4][r];
            s += swz_xor<1>(s); s += swz_xor<2>(s); s += swz_xor<4>(s); s += swz_xor<8>(s);
            if (c == 0) ssq[(w >> 2) * 64 + 16 * I + 4 * g + r] = s; }
        __syncthreads();
#pragma unroll
        for (int r = 0; r < 4; ++r) { const int row = 16 * I + 4 * g + r;
            const float rstd = __builtin_amdgcn_rsqf((ssq[row] + ssq[64 + row]) * (1.0f / 128.0f) + NORM_EPS);
#pragma unroll
            for (int q4 = 0; q4 < 4; ++q4) { const int col = 16 * (vt0 + q4) + c;
                *(LAS unsigned short*)(F.lds + GL_ST + row * 272 + col * 2) = (unsigned short)f2bf(acc[q4][r] * rstd * gng[col]); } }
        __syncthreads();
#pragma unroll
        for (int i2 = 0; i2 < 2; ++i2) { const int id = tid + NTHR * i2, jj = id >> 4, c16 = id & 15;
            const v4u ov = *(const LAS v4u*)(F.lds + GL_ST + jj * 272 + c16 * 16), gv = gvr[i2];
            float o[8], gg[8]; unpack8(ov, o); unpack8(gv, gg);
#pragma unroll
            for (int e = 0; e < 8; ++e) o[e] *= fsilu(gg[e]);
            *(v4u*)(MIX + (t0 + jj) * D + h * 128 + 8 * c16) = pack8(o); }
    }
}
__device__ __forceinline__ void phase_conv(Frame& F, int i) {
    const bf16* Z = (const bf16*)(F.ws + WS_Z); bf16* MIX = (bf16*)(F.ws + WS_M);
    LAS float* glu = (LAS float*)(F.lds + 0);
    LAS float* red = (LAS float*)(F.lds + 126976);
    LAS float* stat = (LAS float*)(F.lds + 128000);
    const int tid = F.tid, half = tid >> 8, cp = tid & 255;
    f32x2 wv[31];
    { const float* cw = INF(I_ECW) + (size_t)i * 31 * 512 + 2 * cp;
#pragma unroll
        for (int w = 0; w < 31; ++w) wv[w] = *(const f32x2*)(cw + w * 512); }
    const f32x2 cb = *(const f32x2*)(INF(I_ECB) + i * 512 + 2 * cp), lg = *(const f32x2*)(INF(I_ELNG) + i * 512 + 2 * cp), lb = *(const f32x2*)(INF(I_ELNB) + i * 512 + 2 * cp);
    for (int k8 = 0; k8 < 8; ++k8) {
        const int u = (int)blockIdx.x * 8 + k8; const int b = u >> 8, s0 = (u & 255) * 32; const size_t t0 = (size_t)b * SEQ + s0;
        __syncthreads();
#pragma unroll
        for (int it = 0; it < 8; ++it) { const int id = tid + NTHR * it;
            if (id < 62 * 64) { const int r = id >> 6, c8 = id & 63, s = s0 - 30 + r;
                float gl[8];
#pragma unroll
                for (int e = 0; e < 8; ++e) gl[e] = 0.f;
                if (s >= 0) { const bf16* zr = Z + ((size_t)b * SEQ + s) * ZE; const v4u av = *(const v4u*)(zr + 1792 + 8 * c8);
                    unpack8(av, gl); }
                *(LAS f32x4*)(glu + r * 512 + 8 * c8) = (f32x4){gl[0], gl[1], gl[2], gl[3]}; *(LAS f32x4*)(glu + r * 512 + 8 * c8 + 4) = (f32x4){gl[4], gl[5], gl[6], gl[7]}; } }
        __syncthreads();
        f32x2 y[16];
#pragma unroll
        for (int tt = 0; tt < 16; ++tt) y[tt] = cb;
#pragma unroll
        for (int r = 0; r < 46; ++r) { const f32x2 gv = *(const LAS f32x2*)(glu + (16 * half + r) * 512 + 2 * cp);
#pragma unroll
            for (int tt = 0; tt < 16; ++tt) if (r - tt >= 0 && r - tt <= 30) y[tt] += gv * wv[r - tt]; }
#pragma unroll
        for (int tt = 0; tt < 16; ++tt) { const float s1 = wave_sum(y[tt].x + y[tt].y), s2 = wave_sum(y[tt].x * y[tt].x + y[tt].y * y[tt].y);
            if (F.lane == 0) { red[(F.wave * 16 + tt) * 2] = s1; red[(F.wave * 16 + tt) * 2 + 1] = s2; } }
        __syncthreads();
        if (tid < 32) { const int hf = tid >> 4, tt = tid & 15; float s1 = 0.f, s2 = 0.f;
#pragma unroll
            for (int w = 0; w < 4; ++w) { s1 += red[((4 * hf + w) * 16 + tt) * 2]; s2 += red[((4 * hf + w) * 16 + tt) * 2 + 1]; }
            const float mean = s1 * (1.0f / 512.0f); const float var = fmaxf(s2 * (1.0f / 512.0f) - mean * mean, 0.f);
            stat[2 * tid] = mean; stat[2 * tid + 1] = __builtin_amdgcn_rsqf(var + NORM_EPS); }
        __syncthreads();
#pragma unroll
        for (int tt = 0; tt < 16; ++tt) { const float mean = stat[2 * (16 * half + tt)], rstd = stat[2 * (16 * half + tt) + 1];
            const f32x2 o = (y[tt] - mean) * rstd * lg + lb;
            *(unsigned*)(MIX + (t0 + 16 * half + tt) * D + 512 + 2 * cp) = pk2(fsilu(o.x), fsilu(o.y)); }
    }
}

#define ATT_DECODE(uu, br, b, h, r, nb, d) do { const int bh_ = (uu) / (64 * nbr), k_ = (uu) - bh_ * (64 * nbr); br = br_lo + (k_ >> 6); const int wi_ = k_ & 63; b = bh_ >> 4; h = bh_ & 15; \
        d = (br == 0) ? 1 : (br == 1 ? 4 : 16); r = wi_ & (d - 1); nb = wi_ / d; } while (0)
#define ATT_LOADKV(kr, vr, b, h, r, nb, d) do { const int pb_ = (nb) > 0 ? (nb) - 1 : 0; _Pragma("unroll") for (int i_ = 0; i_ < 4; ++i_) { const int id_ = tid + NTHR * i_, row_ = id_ >> 3, ch_ = id_ & 7; \
        const int lk_ = 128 * ((i_ < 2) ? pb_ : (nb)) + (row_ & 127); \
        const size_t o_ = ((size_t)((b) * 16 + (h)) * SEQ + (r) + (size_t)(d) * lk_) * 64 + ch_ * 8; kr[i_] = *(const v4u*)(Z + (size_t)T * 1024 + o_); vr[i_] = *(const v4u*)(Z + (size_t)2 * T * 1024 + o_); } } while (0)
#define ATT_STOREKV(kr, vr, buf) do { _Pragma("unroll") for (int i_ = 0; i_ < 4; ++i_) { const int id_ = tid + NTHR * i_, row_ = id_ >> 3, ch_ = id_ & 7; \
        *(LAS v4u*)(F.lds + (buf) * 73728 + row_ * 144 + ch_ * 16) = kr[i_]; *(LAS v4u*)(F.lds + (buf) * 73728 + 36864 + row_ * 144 + ch_ * 16) = vr[i_]; } } while (0)
template <bool MERGE> __device__ __forceinline__ void phase_attn(Frame& F, const int br_lo, const int nbr) {
    const bf16* Z = (const bf16*)(F.ws + WS_Z);
    const int tid = F.tid, lane = F.lane, w = F.wave, c = lane & 15, g = lane >> 4;
    const int per_x = nbr * 1024, x = F.vcu >> 5, cu = F.vcu & 31, nit = per_x >> 5;
    const float* L = (const float*)(F.ws + WS_LSE);
    f32x4 m0, m8;
#pragma unroll
    for (int i = 0; i < 4; ++i) { m0[i] = (4 * g + i >= c) ? 0.f : -1.0e38f; m8[i] = (4 * g + i <= c) ? 0.f : -1.0e38f; }
    v4u kr[4], vr[4];
    int br, b, h, r, nb, d;
    { const int uu = x * per_x + cu; ATT_DECODE(uu, br, b, h, r, nb, d); }
    __syncthreads();
    ATT_LOADKV(kr, vr, b, h, r, nb, d);
    size_t tq = (size_t)b * SEQ + r + (size_t)d * (128 * nb + 16 * w + c);
    bf16x8 q0 = *(const bf16x8*)(Z + ((size_t)(b * 16 + h) * SEQ + (tq & 8191)) * 64 + 8 * g), q1 = *(const bf16x8*)(Z + ((size_t)(b * 16 + h) * SEQ + (tq & 8191)) * 64 + 32 + 8 * g);
    ATT_STOREKV(kr, vr, 0);
    __syncthreads();
    for (int it = 0; it < nit; ++it) {
        const int cur = it & 1;
        int br2 = 0, b2 = 0, h2 = 0, r2 = 0, nb2 = 0, d2 = 1;
        const bool has_next = (it + 1 < nit);
        size_t tq2 = 0; bf16x8 qn0 = q0, qn1 = q1;
        if (has_next) { const int uu = x * per_x + 32 * (it + 1) + cu; ATT_DECODE(uu, br2, b2, h2, r2, nb2, d2); ATT_LOADKV(kr, vr, b2, h2, r2, nb2, d2);
            tq2 = (size_t)b2 * SEQ + r2 + (size_t)d2 * (128 * nb2 + 16 * w + c);
            qn0 = *(const bf16x8*)(Z + ((size_t)(b2 * 16 + h2) * SEQ + (tq2 & 8191)) * 64 + 8 * g); qn1 = *(const bf16x8*)(Z + ((size_t)(b2 * 16 + h2) * SEQ + (tq2 & 8191)) * 64 + 32 + 8 * g); }
        LAS unsigned char* Ks = F.lds + cur * 73728; LAS unsigned char* Vs = Ks + 36864;
        v2u o1[4], o2[4]; float l1 = 0.f, l2 = 0.f;
        if (MERGE) {
            const bf16* O1 = (const bf16*)(F.ws + WS_H); const bf16* O2 = (const bf16*)(F.ws + WS_X1);
#pragma unroll
            for (int dt = 0; dt < 4; ++dt) { o1[dt] = __builtin_nontemporal_load((const v2u*)(O1 + tq * D + h * 64 + 16 * dt + 4 * g)); o2[dt] = __builtin_nontemporal_load((const v2u*)(O2 + tq * D + h * 64 + 16 * dt + 4 * g)); }
            l1 = L[tq * 16 + h]; l2 = L[(size_t)T * 16 + tq * 16 + h];
        }
        f32x4 S[9];
        {
            bf16x8 kf[9][2];
#pragma unroll
            for (int kt = 0; kt < 9; ++kt) { const int row = 16 * w + 16 * kt + c;
                kf[kt][0] = *(const LAS bf16x8*)(Ks + row * 144 + g * 16); kf[kt][1] = *(const LAS bf16x8*)(Ks + row * 144 + 64 + g * 16); }
            __builtin_amdgcn_sched_barrier(0);
#pragma unroll
            for (int kt = 0; kt < 9; ++kt) { f32x4 z = (f32x4){0.f, 0.f, 0.f, 0.f};
                if (kt == 0) z = m0; else if (kt == 8) z = m8;
                z = __builtin_amdgcn_mfma_f32_16x16x32_bf16(kf[kt][0], q0, z, 0, 0, 0); S[kt] = __builtin_amdgcn_mfma_f32_16x16x32_bf16(kf[kt][1], q1, z, 0, 0, 0); }
            if (nb == 0) { asm volatile("" ::: "memory");
#pragma unroll
                for (int kt = 0; kt < 8; ++kt) if (kt < 8 - w) S[kt] = S[kt] + -1.0e38f; }
        }
        bf16x8 vf[5][4];
#pragma unroll
        for (int sp = 0; sp < 5; ++sp) { const int kt0 = 2 * sp, kt1 = (sp < 4) ? 2 * sp + 1 : 8;
            const int rowA = 16 * w + 16 * kt0 + 4 * g + (c >> 2), rowB = 16 * w + 16 * kt1 + 4 * g + (c >> 2);
#pragma unroll
            for (int dt = 0; dt < 4; ++dt) vf[sp][dt] = tr2(Vs + rowA * 144 + (16 * dt + 4 * (c & 3)) * 2, Vs + rowB * 144 + (16 * dt + 4 * (c & 3)) * 2); }
        __builtin_amdgcn_sched_barrier(0);
        float m = -1.0e38f;
#pragma unroll
        for (int kt = 0; kt < 9; ++kt) { m = __builtin_fmaxf(__builtin_fmaxf(m, S[kt][0]), S[kt][1]); m = __builtin_fmaxf(__builtin_fmaxf(m, S[kt][2]), S[kt][3]); }
        m = rows4_max(m);
        typedef float f32x2_ __attribute__((ext_vector_type(2)));
        const f32x2_ m2 = {m, m}; f32x2_ lsum2 = {0.f, 0.f};
#pragma unroll
        for (int kt = 0; kt < 9; ++kt) {
            const f32x2_ a = S[kt].lo - m2, b2_ = S[kt].hi - m2;
            f32x2_ pa, pb; pa.x = __builtin_amdgcn_exp2f(a.x); pa.y = __builtin_amdgcn_exp2f(a.y); pb.x = __builtin_amdgcn_exp2f(b2_.x); pb.y = __builtin_amdgcn_exp2f(b2_.y);
            lsum2 = lsum2 + pa; lsum2 = lsum2 + pb; S[kt].lo = pa; S[kt].hi = pb; }
        float l = lsum2.x + lsum2.y;
        l = rows4_sum(l);
        f32x4 O[4];
#pragma unroll
        for (int dt = 0; dt < 4; ++dt) O[dt] = (f32x4){0.f, 0.f, 0.f, 0.f};
#pragma unroll
        for (int sp = 0; sp < 5; ++sp) {
            const int kt0 = 2 * sp, kt1 = (sp < 4) ? 2 * sp + 1 : 8;
            v4u pbu; pbu.x = pk2(S[kt0][0], S[kt0][1]); pbu.y = pk2(S[kt0][2], S[kt0][3]);
            if (sp < 4) { pbu.z = pk2(S[kt1][0], S[kt1][1]); pbu.w = pk2(S[kt1][2], S[kt1][3]); } else { pbu.z = 0u; pbu.w = 0u; }
            const bf16x8 pb = __builtin_bit_cast(bf16x8, pbu);
#pragma unroll
            for (int dt = 0; dt < 4; ++dt) O[dt] = __builtin_amdgcn_mfma_f32_16x16x32_bf16(vf[sp][dt], pb, O[dt], 0, 0, 0);
        }
        const float inv = frcp(l); const float lse = (m + __builtin_amdgcn_logf(l)) * LN2;
        if (MERGE) {
            const float mx = fmaxf(lse, fmaxf(l1, l2)); float w1 = fexp(l1 - mx), w2 = fexp(l2 - mx), w3 = fexp(lse - mx); const float wi = frcp(w1 + w2 + w3); w1 *= wi; w2 *= wi; w3 *= wi * inv;
            bf16* OUT = (bf16*)(F.ws + WS_M);
#pragma unroll
            for (int dt = 0; dt < 4; ++dt) { v2u o;
                o.x = pk2(w1 * bflo(o1[dt].x) + w2 * bflo(o2[dt].x) + w3 * O[dt][0], w1 * bfhi(o1[dt].x) + w2 * bfhi(o2[dt].x) + w3 * O[dt][1]);
                o.y = pk2(w1 * bflo(o1[dt].y) + w2 * bflo(o2[dt].y) + w3 * O[dt][2], w1 * bfhi(o1[dt].y) + w2 * bfhi(o2[dt].y) + w3 * O[dt][3]);
                *(v2u*)(OUT + tq * D + h * 64 + 16 * dt + 4 * g) = o; }
        } else {
            bf16* Obr = (bf16*)(F.ws + (br == 0 ? WS_H : (br == 1 ? WS_X1 : WS_M))); float* Lbr = (float*)(F.ws + WS_LSE) + (size_t)br * T * 16;
#pragma unroll
            for (int hf = 0; hf < 2; ++hf) { v4u o;
                o.x = pk2(O[2 * hf][0] * inv, O[2 * hf][1] * inv); o.y = pk2(O[2 * hf][2] * inv, O[2 * hf][3] * inv); o.z = pk2(O[2 * hf + 1][0] * inv, O[2 * hf + 1][1] * inv); o.w = pk2(O[2 * hf + 1][2] * inv, O[2 * hf + 1][3] * inv);
                if (br == 2) *(v4u*)(Obr + tq * D + h * 64 + 32 * hf + 8 * g) = o; else __builtin_nontemporal_store(o, (v4u*)(Obr + tq * D + h * 64 + 32 * hf + 8 * g)); }
            if (g == 0) Lbr[tq * 16 + h] = lse;
        }
        __builtin_amdgcn_sched_barrier(0);
        if (has_next) ATT_STOREKV(kr, vr, cur ^ 1);
        __syncthreads();
        br = br2; b = b2; h = h2; r = r2; nb = nb2; d = d2; tq = tq2; q0 = qn0; q1 = qn1;
    }
}
#undef ATT_DECODE
#undef ATT_LOADKV
#undef ATT_STOREKV
__device__ __forceinline__ void phase_attn_merge(Frame& F) {
    const int gw = blockIdx.x * NWAVES + F.wave; const int lane = F.lane;
    const bf16* O1 = (const bf16*)(F.ws + WS_H); const bf16* O2 = (const bf16*)(F.ws + WS_X1); const bf16* O3 = (const bf16*)(F.ws + WS_M);
    unsigned char* OUT8 = F.ws + WS_M8;
    const float* L = (const float*)(F.ws + WS_LSE);
    for (int r = 0; r < 32; r += 2) {
        v2u a[2][4], bq[2][4], cq[2][4]; float l1[2][4], l2[2][4], l3[2][4];
#pragma unroll
        for (int p = 0; p < 2; ++p) { const size_t t = (size_t)gw * 32 + r + p;
#pragma unroll
            for (int j = 0; j < 4; ++j) { const int c = 256 * j + 4 * lane, hd = c >> 6;
                a[p][j] = __builtin_nontemporal_load((const v2u*)(O1 + t * D + c)); bq[p][j] = __builtin_nontemporal_load((const v2u*)(O2 + t * D + c)); cq[p][j] = *(const v2u*)(O3 + t * D + c);
                l1[p][j] = L[t * 16 + hd]; l2[p][j] = L[(size_t)T * 16 + t * 16 + hd]; l3[p][j] = L[(size_t)2 * T * 16 + t * 16 + hd]; } }
#pragma unroll
        for (int p = 0; p < 2; ++p) { const size_t t = (size_t)gw * 32 + r + p;
#pragma unroll
            for (int j = 0; j < 4; ++j) { const int c = 256 * j + 4 * lane;
                const float mx = fmaxf(l1[p][j], fmaxf(l2[p][j], l3[p][j])); float w1 = fexp(l1[p][j] - mx), w2 = fexp(l2[p][j] - mx), w3 = fexp(l3[p][j] - mx); const float inv = frcp(w1 + w2 + w3); w1 *= inv; w2 *= inv; w3 *= inv;
                *(unsigned*)(OUT8 + t * D + c) = pk4_fp8(w1 * bflo(a[p][j].x) + w2 * bflo(bq[p][j].x) + w3 * bflo(cq[p][j].x), w1 * bfhi(a[p][j].x) + w2 * bfhi(bq[p][j].x) + w3 * bfhi(cq[p][j].x),
                                                         w1 * bflo(a[p][j].y) + w2 * bflo(bq[p][j].y) + w3 * bflo(cq[p][j].y), w1 * bfhi(a[p][j].y) + w2 * bfhi(bq[p][j].y) + w3 * bfhi(cq[p][j].y)); } }
    }
}

struct Args { const void* in[26]; float* out; unsigned char* ws; int pad0, pad1; };
__global__ void __launch_bounds__(NTHR, 2) mk_fwd(Args args) {
    extern __shared__ __attribute__((aligned(16))) unsigned char lds_raw[];
    Frame F;
    F.lds = (LAS unsigned char*)lds_raw;
    F.tid = threadIdx.x; F.lane = F.tid & 63; F.wave = __builtin_amdgcn_readfirstlane(F.tid >> 6);
    F.G = gridDim.x; { const int bx = blockIdx.x; F.vcu = (F.G % 8 == 0) ? (bx % 8) * (F.G / 8) + bx / 8 : bx; }
    F.ws = args.ws; F.out = args.out; F.ctl = (gu32*)(args.ws + WS_CTL);
    volatile LAS unsigned* MISC = (volatile LAS unsigned*)(F.lds + LDS_MISC);
    if (F.tid < 64) MISC[F.tid] = 0u;
    __syncthreads();
    XcdBarrier bar = xcd_barrier_post((unsigned*)(F.ctl + CW_BAR), MISC);
    const int wave_s = F.wave;
#define FRESH() do { int w_ = wave_s; asm volatile("" : "+s"(w_)); int t_; asm volatile("v_mbcnt_lo_u32_b32 %0, -1, 0\n\tv_mbcnt_hi_u32_b32 %0, -1, %0" : "=v"(t_)); t_ += w_ * 64; F.tid = t_; F.lane = t_ & 63; F.wave = w_; int v_ = F.vcu; asm volatile("" : "+s"(v_)); F.vcu = v_; } while (0)
#define SEAM() do { XcdBarrier b_ = bar; asm volatile("" : "+s"(b_.x), "+s"(b_.bar)); int w_ = wave_s; asm volatile("" : "+s"(w_)); int t_; asm volatile("v_mbcnt_lo_u32_b32 %0, -1, 0\n\tv_mbcnt_hi_u32_b32 %0, -1, %0" : "=v"(t_)); xcd_barrier(b_, (t_ + w_ * 64) == 0); } while (0)
#ifndef MK_OFF
#define MK_OFF 0
#endif
#define ON(n) (!(((MK_OFF) >> (n)) & 1))
#ifndef MK_REP
#define MK_REP 0
#endif
#define NREP(n) ((((MK_REP) >> (n)) & 1) ? 2 : 1)
#define PROBE(n) (((MK_REP) >> (n)) & 1)
    bf16* const H = (bf16*)(F.ws + WS_H); bf16* const M_ = (bf16*)(F.ws + WS_M); bf16* const Z = (bf16*)(F.ws + WS_Z); bf16* const HID = (bf16*)(F.ws + WS_HID);

    if (ON(0)) for (int rep = 0; rep < NREP(0); ++rep) { FRESH(); phase_prologue(F); FRESH(); convert_moe(F, 0); }
    SEAM();
    for (int l = 0; l < DEPTH; ++l) {
        const int i = l >> 1; const bool odd = (l & 1) != 0;
#if defined(MK_SLEEP_US)
        for (int s_ = 0; s_ < (MK_SLEEP_US) / 4; ++s_) __builtin_amdgcn_s_sleep(127);
#endif
        if (ON(1)) { FRESH(); if (l > 0) for (int rep = 0; rep < NREP(1); ++rep) convert_moe(F, l); for (int rep = PROBE(16) ? 0 : 1; rep < 2; ++rep) { FRESH(); phase_n1(F, l, rep == 1 ? 1.0f : 0.0f); } }
        __syncthreads();
        for (int rep = 0; rep < NREP(2); ++rep) { FRESH();
            if (ON(2) && !odd) { pg8::Gemm g{H, (const bf16*)(F.ws + WS_WIN) + (size_t)i * ZEW * 1024, T, ZEW, 1024}; pg8::PanelOrder S{(int)blockIdx.x, ZEW / 256};
                pg8::EpiZe E{Z, ZE};
                pg8::gemm_phase<pg8::EpiZe, pg8::PanelOrder, true, true>(F.lds, g, S, E, F.wave); }
            else if (ON(3)) { pg8::Gemm g{H, (const bf16*)(F.ws + WS_WQKV + (size_t)i * ZO * 1024), T, ZO, 512}; pg8::PanelOrder S{(int)blockIdx.x, ZO / 256};
                { const f32x4* csg = (const f32x4*)(F.ws + WS_CS) + (size_t)blockIdx.x * 256 * 4; LAS f32x4* csl = (LAS f32x4*)(F.lds + LDS_CSROWS);
                  for (int q_ = F.tid; q_ < 256 * 4; q_ += NTHR) csl[q_] = csg[q_]; }
                pg8::EpiQkv E{Z, ZO, (const LAS float*)(F.lds + LDS_CSROWS), 1.0f / W8_SCALE};
                pg8::gemm_phase<pg8::EpiQkv, pg8::PanelOrder, true, true, false, true>(F.lds, g, S, E, F.wave); }
        }
        if (!odd) {
            __syncthreads();
            if (ON(4)) for (int rep = 0; rep < NREP(3); ++rep) { FRESH(); phase_gla_kv(F, i); }
            SEAM();
            if (ON(5)) { FRESH(); phase_gla_scan(F); }
            SEAM();
            { FRESH(); if (ON(6)) for (int rep = 0; rep < NREP(6); ++rep) phase_gla_out(F, i); if (ON(7)) for (int rep = 0; rep < NREP(7); ++rep) phase_conv(F, i); }
            __syncthreads();
        } else {
            SEAM();
            if (ON(8)) for (int rep = 0; rep < NREP(4); ++rep) { FRESH(); phase_attn<false>(F, 0, 3); }
            SEAM();
            if (ON(9)) { FRESH(); phase_attn_merge(F); }
            __syncthreads();
        }
        if (ON(10)) for (int rep = 0; rep < NREP(8); ++rep) { FRESH();
            pg8::PanelOrder S{(int)blockIdx.x, 4};
            if (!odd) { pg8::Gemm g{M_, (const bf16*)(F.ws + WS_WOE) + (size_t)i * 1024 * 1024, T, 1024, 1024}; pg8::EpiStore E{H, 1024, 4, 1.0f};
                pg8::gemm_phase<pg8::EpiStore, pg8::PanelOrder, true, true>(F.lds, g, S, E, F.wave); }
            else { pg8::Gemm g{(const bf16*)(F.ws + WS_M8), (const bf16*)(F.ws + WS_WOO + (size_t)i * 1024 * 1024), T, 1024, 512}; pg8::EpiStoreT<false, true> E{H, 1024, 4, 1.0f / W8_SCALE};
                pg8::gemm_phase<pg8::EpiStoreT<false, true>, pg8::PanelOrder, true, true, false, true>(F.lds, g, S, E, F.wave); }
        }
        __syncthreads();
        if (ON(11)) { FRESH(); for (int rep = PROBE(17) ? 0 : 1; rep < 2; ++rep) { FRESH(); phase_n2(F, l, rep == 0); __syncthreads(); } }
        SEAM();
        if (ON(13)) for (int rep = 0; rep < NREP(9); ++rep) { FRESH();
            build_tstart(F, l);
            pg8::Gemm g{(const bf16*)(F.ws + WS_H8), (const bf16*)(F.ws + WS_W13), PMAX, 1024, 512};
            pg8::GroupOrder S{(const LAS int*)(F.lds + LDS_TAB), F.G, F.vcu, CAPE};
            pg8::EpiSwiglu E{HID, 1.0f / W8_SCALE};
            pg8::gemm_phase<pg8::EpiSwiglu, pg8::GroupOrder, true, true, true, true>(F.lds, g, S, E, F.wave, (const int*)(F.ws + WS_EXPTOK), (unsigned)T);
        }
        SEAM();
        if (ON(14)) for (int rep = 0; rep < NREP(10); ++rep) { FRESH();
            build_tstart(F, l);
            int k2_ = 256; asm volatile("" : "+s"(k2_));
            pg8::Gemm g{HID, (const bf16*)(F.ws + WS_W2), PMAX, 1024, k2_}; pg8::GroupOrder S{(const LAS int*)(F.lds + LDS_TAB), F.G, F.vcu, CAPE};
            pg8::EpiStoreDn E{F.ws + WS_YS};
            pg8::gemm_phase<pg8::EpiStoreDn, pg8::GroupOrder, true, true, false, true>(F.lds, g, S, E, F.wave);
        }
        SEAM();
    }
    if (ON(15)) { FRESH(); phase_n1(F, DEPTH); }
#undef SEAM
}

extern "C" void kernel_launch(void* const* d_in, const int* in_sizes, int n_in, void* d_out, int out_size, void* d_ws, size_t ws_size, hipStream_t stream) {
    static int grid = 0;
    if (grid == 0) {
        if (n_in != 26 || out_size != T * D || ws_size < WS_END) { fprintf(stderr, "kernel_launch: unexpected problem (n_in %d, out %d, ws %zu < %zu); nothing launched\n", n_in, out_size, ws_size, (size_t)WS_END); grid = -1; return; }
        if (hipFuncSetAttribute((const void*)mk_fwd, hipFuncAttributeMaxDynamicSharedMemorySize, LDS_BYTES) != hipSuccess) { fprintf(stderr, "kernel_launch: hipFuncSetAttribute failed\n"); grid = -1; return; }
        int per_cu = 0;
        if (hipOccupancyMaxActiveBlocksPerMultiprocessor(&per_cu, (const void*)mk_fwd, NTHR, LDS_BYTES) != hipSuccess || per_cu < 1) fprintf(stderr, "kernel_launch: occupancy query reports %d\n", per_cu);
        (void)hipGetLastError();
        grid = 256;
    }
    if (grid < 0) return;
    if (hipMemsetAsync((char*)d_ws + WS_CTL, 0, CTL_ZERO_BYTES, stream) != hipSuccess) { fprintf(stderr, "kernel_launch: memset failed\n"); return; }
    Args a{};
    for (int i = 0; i < 26; ++i) a.in[i] = d_in[i];
    a.out = (float*)d_out; a.ws = (unsigned char*)d_ws;
    hipLaunchKernelGGL(mk_fwd, dim3(grid), dim3(NTHR), LDS_BYTES, stream, a);
    const hipError_t le = hipPeekAtLastError();
    if (le != hipSuccess) fprintf(stderr, "kernel_launch: launch failed: %s\n", hipGetErrorName(le));
}
```

```cpp
#include <hip/hip_runtime.h>
#include <cstdio>
#include <cstdint>
namespace pg8 {
#define PG8_LAS __attribute__((address_space(3)))
typedef unsigned short bf16_t;
typedef short bf16x8 __attribute__((ext_vector_type(8)));
typedef float f32x4 __attribute__((ext_vector_type(4)));
typedef unsigned u32x4 __attribute__((ext_vector_type(4)));
constexpr int BM = 256, BK = 64, HALF = 128, HTB = HALF * BK * 2  , STAGE_BYTES = 8 * HTB, NXCD = 8, WGM = 8;

__host__ __device__ __forceinline__ int lds_byte(int r, int c) { const int st = (r >> 4) * 2 + (c >> 5), rr = r & 15, cc = c & 31, ob = rr * 64 + cc * 2; return st * 1024 + (ob ^ (((ob >> 9) & 1) << 5)); }
__host__ __device__ __forceinline__ void stage_rc(int b, int& R, int& C) { const int st = b / 1024, sb = b % 1024, swz = sb ^ (((sb >> 9) & 1) << 5); R = (st >> 1) * 16 + swz / 64; C = (st & 1) * 32 + (swz % 64) / 2; }
__host__ __device__ __forceinline__ int perm32(int rho) { const int n = rho >> 4, i = rho & 15; return 8 * (i >> 2) + 4 * n + (i & 3); }

struct Unit { int pm, pn; };
struct Gemm { const bf16_t* A; const bf16_t* Bt; int M, N, K; };

struct StaticOrder {
    int nM, nN, nwg, G, c;
    __host__ __device__ void init(int M, int N, int G_, int c_) { nM = M / BM; nN = N / BM; nwg = nM * nN; G = G_; c = c_; }
    __host__ __device__ bool next(int i, Unit& u) const {
        const long L = (long)i * G + c; if (L >= nwg) return false;
        int wgid = (int)L; { const int q = nwg / NXCD, r = nwg % NXCD, xcd = wgid % NXCD, off = wgid / NXCD; wgid = (xcd < r ? xcd * (q + 1) : r * (q + 1) + (xcd - r) * q) + off; }
        const int nig = WGM * nN, gid = wgid / nig, fm = gid * WGM, gsz = (nM - fm) < WGM ? (nM - fm) : WGM;
        u.pm = fm + ((wgid % nig) % gsz); u.pn = (wgid % nig) / gsz; return true;
    }
    __device__ __forceinline__ void a_ready(const Unit&) const {}
    __device__ __forceinline__ void done(const Unit&) const {}
};

__device__ __forceinline__ unsigned cvt_pk_bf16(float lo, float hi) { unsigned r; asm volatile("v_cvt_pk_bf16_f32 %0, %1, %2" : "=v"(r) : "v"(lo), "v"(hi)); return r; }
typedef float f32x2 __attribute__((ext_vector_type(2)));
__device__ __forceinline__ float swz_xor16(float v) { return __builtin_bit_cast(float, __builtin_amdgcn_ds_swizzle(__builtin_bit_cast(int, v), (16 << 10) | 0x1F)); }
__device__ __forceinline__ float fast_exp(float x) { return __builtin_amdgcn_exp2f(x * 1.4426950408889634f); }
__device__ __forceinline__ float fast_silu(float x) { return x * __builtin_amdgcn_rcpf(1.0f + fast_exp(-x)); }

template <bool NT, bool SC = false> struct EpiStoreT {
    static constexpr bool PERM = true, AFTER_DRAIN = false;
    bf16_t* O; int ldc; int nN; float sc;
    __device__ __forceinline__ void operator()(const f32x4 (&acc)[2][2][4][2], const Unit& u, int wr, int wc, int fr, int fq) const {
        int pm_ = u.pm; asm volatile("" : "+s"(pm_));
        const int row0 = pm_ * BM + wr * 64 + fr; const int col0 = (u.pn % nN) * BM + wc * 32 + 8 * fq;
#pragma unroll
        for (int ai = 0; ai < 2; ++ai)
#pragma unroll
            for (int m = 0; m < 4; ++m) { bf16_t* rowp = O + (size_t)(row0 + ai * HALF + m * 16) * ldc + col0;
#pragma unroll
                for (int bj = 0; bj < 2; ++bj) { f32x4 v0 = acc[ai][bj][m][0], v1 = acc[ai][bj][m][1];
                    if constexpr (SC) { v0 = v0 * sc; v1 = v1 * sc; }
                    u32x4 w; w.x = cvt_pk_bf16(v0[0], v0[1]); w.y = cvt_pk_bf16(v0[2], v0[3]); w.z = cvt_pk_bf16(v1[0], v1[1]); w.w = cvt_pk_bf16(v1[2], v1[3]);
                    if constexpr (NT) __builtin_nontemporal_store(w, (u32x4*)(rowp + bj * HALF)); else *(u32x4*)(rowp + bj * HALF) = w; } }
    }
};
typedef EpiStoreT<false> EpiStore;

struct EpiZe {
    static constexpr bool PERM = true, AFTER_DRAIN = false;
    bf16_t* O; int ldc;
    __device__ __forceinline__ void operator()(const f32x4 (&acc)[2][2][4][2], const Unit& u, int wr, int wc, int fr, int fq) const {
        int pm_ = u.pm; asm volatile("" : "+s"(pm_));
        const int row0 = pm_ * BM + wr * 64 + fr;
        if (u.pn < 7) {
            const int col0 = u.pn * BM + wc * 32 + 8 * fq;
#pragma unroll
            for (int ai = 0; ai < 2; ++ai)
#pragma unroll
                for (int m = 0; m < 4; ++m) { bf16_t* rowp = O + (size_t)(row0 + ai * HALF + m * 16) * ldc + col0;
#pragma unroll
                    for (int bj = 0; bj < 2; ++bj) { const f32x4 v0 = acc[ai][bj][m][0], v1 = acc[ai][bj][m][1];
                        u32x4 w; w.x = cvt_pk_bf16(v0[0], v0[1]); w.y = cvt_pk_bf16(v0[2], v0[3]); w.z = cvt_pk_bf16(v1[0], v1[1]); w.w = cvt_pk_bf16(v1[2], v1[3]);
                        __builtin_nontemporal_store(w, (u32x4*)(rowp + bj * HALF)); } }
        } else {
            const int col0 = 1792 + (u.pn - 7) * 128 + wc * 32 + 8 * fq;
#pragma unroll
            for (int ai = 0; ai < 2; ++ai)
#pragma unroll
                for (int m = 0; m < 4; ++m) {
                    const f32x4 a0 = acc[ai][0][m][0], a1 = acc[ai][0][m][1], b0 = acc[ai][1][m][0], b1 = acc[ai][1][m][1];
                    f32x4 g0, g1;
#pragma unroll
                    for (int i = 0; i < 4; ++i) { g0[i] = a0[i] * __builtin_amdgcn_rcpf(1.0f + fast_exp(-b0[i])); g1[i] = a1[i] * __builtin_amdgcn_rcpf(1.0f + fast_exp(-b1[i])); }
                    u32x4 w; w.x = cvt_pk_bf16(g0[0], g0[1]); w.y = cvt_pk_bf16(g0[2], g0[3]); w.z = cvt_pk_bf16(g1[0], g1[1]); w.w = cvt_pk_bf16(g1[2], g1[3]);
                    __builtin_nontemporal_store(w, (u32x4*)(O + (size_t)(row0 + ai * HALF + m * 16) * ldc + col0)); }
        }
    }
};

struct EpiStoreDn {
    static constexpr bool PERM = true, AFTER_DRAIN = false;
    unsigned char* O;
    __device__ __forceinline__ void operator()(const f32x4 (&acc)[2][2][4][2], const Unit& u, int wr, int wc, int fr, int fq) const {
        int pm_ = u.pm; asm volatile("" : "+s"(pm_));
        const int row0 = pm_ * BM + wr * 64 + fr; const int col0 = (u.pn & 3) * BM + wc * 64 + 16 * fq;
#pragma unroll
        for (int ai = 0; ai < 2; ++ai)
#pragma unroll
            for (int m = 0; m < 4; ++m) { u32x4 w;
#pragma unroll
                for (int bj = 0; bj < 2; ++bj) { const f32x4 v0 = acc[ai][bj][m][0] * 0.5f, v1 = acc[ai][bj][m][1] * 0.5f;
                    float q0[4], q1[4];
#pragma unroll
                    for (int i = 0; i < 4; ++i) { q0[i] = __builtin_amdgcn_fmed3f(v0[i], -448.f, 448.f); q1[i] = __builtin_amdgcn_fmed3f(v1[i], -448.f, 448.f); }
                    int t0_ = 0, t1_ = 0;
                    t0_ = __builtin_amdgcn_cvt_pk_fp8_f32(q0[0], q0[1], t0_, false); t0_ = __builtin_amdgcn_cvt_pk_fp8_f32(q0[2], q0[3], t0_, true);
                    t1_ = __builtin_amdgcn_cvt_pk_fp8_f32(q1[0], q1[1], t1_, false); t1_ = __builtin_amdgcn_cvt_pk_fp8_f32(q1[2], q1[3], t1_, true);
                    if (bj == 0) { w.x = (unsigned)t0_; w.y = (unsigned)t1_; } else { w.z = (unsigned)t0_; w.w = (unsigned)t1_; } }
                __builtin_nontemporal_store(w, (u32x4*)(O + (size_t)(row0 + ai * HALF + m * 16) * 1024 + col0)); }
    }
};

struct EpiQkv {
    static constexpr bool PERM = true, AFTER_DRAIN = false;
    bf16_t* O; int ldc; const PG8_LAS float* cs; float wscale;
    __device__ __forceinline__ void operator()(const f32x4 (&acc)[2][2][4][2], const Unit& u, int wr, int wc, int fr, int fq) const {
        int pm_ = u.pm; asm volatile("" : "+s"(pm_));
        const int row0 = pm_ * BM + wr * 64 + fr;
        const size_t img = (size_t)(u.pn >> 2) * ((size_t)65536 * 1024); const int head0 = (u.pn & 3) * 4 + (wc >> 1), d0 = (wc & 1) * 32 + 8 * fq;
        const bool roped = (u.pn < 8) && ((wc & 1) == 0);
        const float qs = ((u.pn < 4) ? 0.125f * 1.4426950408889634f : 1.0f) * wscale;
        const float sgn = (fq == 0) ? -1.0f : 1.0f;
#pragma unroll
        for (int ai = 0; ai < 2; ++ai)
#pragma unroll
            for (int m = 0; m < 4; ++m) { const int row = row0 + ai * HALF + m * 16; const int bb = row >> 13, ss = row & 8191;
                f32x4 c0 = {1.f, 1.f, 1.f, 1.f}, c1 = c0, s0 = {0.f, 0.f, 0.f, 0.f}, s1 = s0;
                if (roped) { const PG8_LAS f32x4* cp = (const PG8_LAS f32x4*)(cs + (wr * 64 + fr + ai * HALF + m * 16) * 16); c0 = cp[0]; c1 = cp[1]; s0 = cp[2]; s1 = cp[3]; }
#pragma unroll
                for (int bj = 0; bj < 2; ++bj) { f32x4 v0 = acc[ai][bj][m][0], v1 = acc[ai][bj][m][1];
                    if (roped) {
                        f32x4 p0, p1;
#pragma unroll
                        for (int i = 0; i < 4; ++i) { p0[i] = swz_xor16(v0[i]); p1[i] = swz_xor16(v1[i]); }
                        if (fq < 2) { v0 = v0 * c0 + (p0 * s0) * sgn; v1 = v1 * c1 + (p1 * s1) * sgn; }
                    }
                    v0 = v0 * qs; v1 = v1 * qs;
                    u32x4 w; w.x = cvt_pk_bf16(v0[0], v0[1]); w.y = cvt_pk_bf16(v0[2], v0[3]); w.z = cvt_pk_bf16(v1[0], v1[1]); w.w = cvt_pk_bf16(v1[2], v1[3]);
                    __builtin_nontemporal_store(w, (u32x4*)(O + img + ((size_t)((bb * 16 + head0 + 2 * bj) * 8192 + ss)) * 64 + d0)); }
                __builtin_amdgcn_sched_barrier(0); }
    }
};

struct EpiSwiglu {
    static constexpr bool PERM = true, AFTER_DRAIN = false;
    bf16_t* O;
    float wscale;
    __device__ __forceinline__ void operator()(const f32x4 (&acc)[2][2][4][2], const Unit& u, int wr, int wc, int fr, int fq) const {
        const int row0 = u.pm * BM + wr * 64 + fr; const int col0 = (u.pn & 3) * 128 + wc * 32 + 8 * fq;
#pragma unroll
        for (int ai = 0; ai < 2; ++ai)
#pragma unroll
            for (int m = 0; m < 4; ++m) {
                const f32x4 a0 = acc[ai][0][m][0], a1 = acc[ai][0][m][1], b0 = acc[ai][1][m][0], b1 = acc[ai][1][m][1];
                f32x4 h0, h1;
#pragma unroll
                for (int i = 0; i < 4; ++i) { h0[i] = fast_silu(a0[i] * wscale) * (b0[i] * wscale); h1[i] = fast_silu(a1[i] * wscale) * (b1[i] * wscale); }
                typedef unsigned u32x2_ __attribute__((ext_vector_type(2)));
                u32x2_ w; { int t0_ = 0, t1_ = 0;
                    float q0[4], q1[4];
#pragma unroll
                    for (int i = 0; i < 4; ++i) { q0[i] = __builtin_amdgcn_fmed3f(h0[i], -448.f, 448.f); q1[i] = __builtin_amdgcn_fmed3f(h1[i], -448.f, 448.f); }
                    t0_ = __builtin_amdgcn_cvt_pk_fp8_f32(q0[0], q0[1], t0_, false); t0_ = __builtin_amdgcn_cvt_pk_fp8_f32(q0[2], q0[3], t0_, true);
                    t1_ = __builtin_amdgcn_cvt_pk_fp8_f32(q1[0], q1[1], t1_, false); t1_ = __builtin_amdgcn_cvt_pk_fp8_f32(q1[2], q1[3], t1_, true);
                    w.x = (unsigned)t0_; w.y = (unsigned)t1_; }
                *(u32x2_*)((unsigned char*)O + (size_t)(row0 + ai * HALF + m * 16) * 512 + col0) = w; }
    }
};

struct GroupOrder {
    const PG8_LAS int* tstart; int G, v; int cape;
    __device__ __forceinline__ long gather_off(const Unit& u) const { const int e = u.pn >> 2; return (long)e * cape - (long)tstart[e] * BM; }
    __device__ __forceinline__ bool next(int i, Unit& u) const {
        const int L = i * G + v; const int nt = tstart[32];
        if (L >= nt * 4) return false;
        const int pm = L >> 2; int e = 0;
#pragma unroll
        for (int k = 1; k < 32; ++k) e += (tstart[k] <= pm) ? 1 : 0;
        u.pm = __builtin_amdgcn_readfirstlane(pm); u.pn = __builtin_amdgcn_readfirstlane(e * 4 + (L & 3)); return true;
    }
    __device__ __forceinline__ void a_ready(const Unit&) const {}
    __device__ __forceinline__ void done(const Unit&) const {}
};

struct PanelOrder {
    int pm, nN;
    __device__ __forceinline__ bool next(int i, Unit& u) const { if (i >= nN) return false; u.pm = pm; u.pn = i; return true; }
    __device__ __forceinline__ void a_ready(const Unit&) const {}
    __device__ __forceinline__ void done(const Unit&) const {}
};

template <class Epi, class Sched, bool ALIGN_EPI = false, bool SP2 = false, bool GATHER = false, bool F8 = false>
__device__ __forceinline__ void gemm_phase(PG8_LAS unsigned char* lds, const Gemm g, const Sched& S, const Epi& E, const int wave_in, const int* rowidx = nullptr, const unsigned nrows = 0) {
    static_assert(!GATHER || SP2, "GATHER is implemented for the SP2 loop");
    int tid_; asm volatile("v_mbcnt_lo_u32_b32 %0, -1, 0\n\tv_mbcnt_hi_u32_b32 %0, -1, %0" : "=v"(tid_)); tid_ += wave_in * 64;
    const int tid = tid_, wid = __builtin_amdgcn_readfirstlane(tid >> 6), lane = tid & 63, wr = wid >> 2, wc = wid & 3, fr = lane & 15, fq = lane >> 4;
    const int K = g.K, nt = K / BK;
    unsigned voffA[2], voffB[2];
#pragma unroll
    for (int i = 0; i < 2; ++i) { int R, C; stage_rc(tid * 16 + i * 8192, R, C); const int Rb = Epi::PERM ? ((R & ~31) + perm32(R & 31)) : R;
        voffA[i] = (unsigned)(R * K + C) * 2u; voffB[i] = (unsigned)(Rb * K + C) * 2u; }
    int sR[2], sC[2];
#pragma unroll
    for (int i = 0; i < 2; ++i) stage_rc(tid * 16 + i * 8192, sR[i], sC[i]);
    unsigned ga[2][2];
#define PG8_GOFF(dst, pm_)    do { _Pragma("unroll") for (int h_ = 0; h_ < 2; ++h_) _Pragma("unroll") for (int i_ = 0; i_ < 2; ++i_) { \
        unsigned r_ = (unsigned)rowidx[S.gather_off(pm_) + (long)(pm_).pm * BM + h_ * HALF + sR[i_]]; r_ = r_ < nrows ? r_ : nrows - 1u; dst[h_][i_] = (r_ * (unsigned)K + (unsigned)sC[i_]) * 2u; } } while (0)
#define PG8_STAGE_GA(bufoff, kbyte, h) do { _Pragma("unroll") for (int _i = 0; _i < 2; ++_i) { unsigned vo_ = ga[h][_i]; asm volatile("" : "+v"(vo_)); \
        __builtin_amdgcn_global_load_lds((const unsigned*)((const char*)g.A + (size_t)(kbyte) + vo_), (PG8_LAS unsigned*)(lds + (bufoff) + ldsw + _i * 8192), 16, 0, 0); } } while (0)
    const size_t kstep = (size_t)(BK * 2);
    const size_t hstep = (size_t)HALF * K * 2;
    const size_t tstep = 2 * hstep;
    const unsigned ldsw = (unsigned)wid * 1024u;
    const int aoff = lds_byte(wr * 64 + fr, fq * 8), boff = lds_byte(wc * 32 + fr, fq * 8);
#define PG8_SA(b, h) (((b) * 2 + (h)) * HTB)
#define PG8_SB(b, h) ((4 + (b) * 2 + (h)) * HTB)
#define PG8_STAGE(bufoff, gbase, voff) do { _Pragma("unroll") for (int _i = 0; _i < 2; ++_i) { unsigned vo_ = (voff)[_i]; asm volatile("" : "+v"(vo_));     \
        __builtin_amdgcn_global_load_lds((const unsigned*)((const char*)(gbase) + vo_), (PG8_LAS unsigned*)(lds + (bufoff) + ldsw + _i * 8192), 16, 0, 0); } } while (0)
#define PG8_LDA(dst, b, h) do { _Pragma("unroll") for (int m = 0; m < 4; ++m) _Pragma("unroll") for (int k = 0; k < 2; ++k) dst[m][k] = *(const PG8_LAS bf16x8*)(lds + PG8_SA(b, h) + aoff + m * 2048 + k * 1024); } while (0)
#define PG8_LDB(dst, b, h) do { _Pragma("unroll") for (int n = 0; n < 2; ++n) _Pragma("unroll") for (int k = 0; k < 2; ++k) dst[n][k] = *(const PG8_LAS bf16x8*)(lds + PG8_SB(b, h) + boff + n * 2048 + k * 1024); } while (0)
#define PG8_MMA(ai, bj, At, Bt) do { __builtin_amdgcn_s_setprio(1); _Pragma("unroll") for (int m = 0; m < 4; ++m) _Pragma("unroll") for (int n = 0; n < 2; ++n) _Pragma("unroll") for (int k = 0; k < 2; ++k) { \
        if constexpr (F8) { if (k == 0) { typedef int i4_t __attribute__((ext_vector_type(4))); \
            acc[ai][bj][m][n] = __builtin_amdgcn_mfma_scale_f32_16x16x128_f8f6f4(__builtin_shufflevector(__builtin_bit_cast(i4_t, Bt[n][0]), __builtin_bit_cast(i4_t, Bt[n][1]), 0, 1, 2, 3, 4, 5, 6, 7), \
                __builtin_shufflevector(__builtin_bit_cast(i4_t, At[m][0]), __builtin_bit_cast(i4_t, At[m][1]), 0, 1, 2, 3, 4, 5, 6, 7), acc[ai][bj][m][n], 0, 0, 0, 0, 0, 0); } } \
        else acc[ai][bj][m][n] = __builtin_amdgcn_mfma_f32_16x16x32_bf16(Bt[n][k], At[m][k], acc[ai][bj][m][n], 0, 0, 0); } __builtin_amdgcn_s_setprio(0); } while (0)
#define PG8_WAIT_V(n) asm volatile("s_waitcnt vmcnt(" #n ")" ::: "memory")
#define PG8_WAIT_L(n) asm volatile("s_waitcnt lgkmcnt(" #n ")" ::: "memory")
#define PG8_BAR __builtin_amdgcn_s_barrier()
#define PG8_SCHED __builtin_amdgcn_sched_barrier(0)
    Unit cur, nxt; int ui = 0;
    if (!S.next(0, cur)) return;
    f32x4 acc[2][2][4][2];
#pragma unroll
    for (int a = 0; a < 2; ++a)
#pragma unroll
        for (int b = 0; b < 2; ++b)
#pragma unroll
            for (int m = 0; m < 4; ++m)
#pragma unroll
                for (int n = 0; n < 2; ++n) acc[a][b][m][n] = (f32x4){0.f, 0.f, 0.f, 0.f};
    bf16x8 At[4][2], B0[2][2], B1[2][2];
    const char* cA = (const char*)g.A + (size_t)cur.pm * tstep; const char* cB = (const char*)g.Bt + (size_t)cur.pn * tstep;
    S.a_ready(cur);
    if constexpr (SP2) {
        if constexpr (GATHER) { PG8_GOFF(ga, cur);
        PG8_STAGE(PG8_SB(0, 0), cB, voffB); PG8_STAGE(PG8_SB(0, 1), cB + hstep, voffB); PG8_STAGE_GA(PG8_SA(0, 0), 0, 0); PG8_STAGE_GA(PG8_SA(0, 1), 0, 1);
        } else {
        PG8_STAGE(PG8_SB(0, 0), cB, voffB); PG8_STAGE(PG8_SB(0, 1), cB + hstep, voffB); PG8_STAGE(PG8_SA(0, 0), cA, voffA); PG8_STAGE(PG8_SA(0, 1), cA + hstep, voffA); }
        if (wr == 1) PG8_BAR;
        PG8_WAIT_V(2); PG8_BAR;
        if constexpr (GATHER) { PG8_STAGE(PG8_SB(1, 0), cB + kstep, voffB); PG8_STAGE_GA(PG8_SA(1, 0), kstep, 0); PG8_STAGE(PG8_SB(1, 1), cB + hstep + kstep, voffB); } else {
        PG8_STAGE(PG8_SB(1, 0), cB + kstep, voffB); PG8_STAGE(PG8_SA(1, 0), cA + kstep, voffA); PG8_STAGE(PG8_SB(1, 1), cB + hstep + kstep, voffB); }
        PG8_WAIT_V(6); PG8_BAR;
    } else {
        PG8_STAGE(PG8_SB(0, 0), cB, voffB); PG8_STAGE(PG8_SA(0, 0), cA, voffA); PG8_STAGE(PG8_SB(0, 1), cB + hstep, voffB); PG8_STAGE(PG8_SA(0, 1), cA + hstep, voffA);
        if (wr == 1) PG8_BAR;
        PG8_WAIT_V(4); PG8_BAR;
        PG8_STAGE(PG8_SB(1, 0), cB + kstep, voffB); PG8_STAGE(PG8_SA(1, 0), cA + kstep, voffA); PG8_STAGE(PG8_SB(1, 1), cB + hstep + kstep, voffB);
        PG8_WAIT_V(6); PG8_BAR;
    }
    for (;;) {
        const bool has_next = S.next(ui + 1, nxt);
        unsigned gn[2][2];
        if constexpr (GATHER) { if (has_next) PG8_GOFF(gn, nxt); else { _Pragma("unroll") for (int h_ = 0; h_ < 2; ++h_) _Pragma("unroll") for (int i_ = 0; i_ < 2; ++i_) gn[h_][i_] = ga[h_][i_]; } }
        const char* nA = has_next ? (const char*)g.A + (size_t)nxt.pm * tstep : cA; const char* nB = has_next ? (const char*)g.Bt + (size_t)nxt.pn * tstep : cB;
        for (int t = 0; t < nt; t += 2) {
            const bool last = (t == nt - 2);
            const char* a1 = cA + (size_t)(t + 1) * kstep;
            const char* a2 = last ? nA : cA + (size_t)(t + 2) * kstep; const char* b2 = last ? nB : cB + (size_t)(t + 2) * kstep;
            const char* a3 = a2 + kstep; const char* b3 = b2 + kstep;
            if (last && has_next) S.a_ready(nxt);
            if constexpr (SP2) {
            const size_t kb2 = last ? (size_t)0 : (size_t)(t + 2) * kstep;
            PG8_LDB(B0, 0, 0); PG8_LDB(B1, 0, 1); PG8_SCHED; PG8_LDA(At, 0, 0);
            if constexpr (GATHER) { PG8_STAGE_GA(PG8_SA(1, 1), (size_t)(t + 1) * kstep, 1);
                if (last) { _Pragma("unroll") for (int h_ = 0; h_ < 2; ++h_) _Pragma("unroll") for (int i_ = 0; i_ < 2; ++i_) ga[h_][i_] = gn[h_][i_]; } }
            else PG8_STAGE(PG8_SA(1, 1), a1 + hstep, voffA);
            PG8_WAIT_V(8); PG8_WAIT_L(0); PG8_BAR; PG8_MMA(0, 0, At, B0); PG8_MMA(0, 1, At, B1); PG8_BAR; PG8_SCHED;
            PG8_LDA(At, 0, 1); PG8_STAGE(PG8_SB(0, 0), b2, voffB); PG8_STAGE(PG8_SB(0, 1), b2 + hstep, voffB);
            if constexpr (GATHER) PG8_STAGE_GA(PG8_SA(0, 0), kb2, 0); else PG8_STAGE(PG8_SA(0, 0), a2, voffA);
            PG8_WAIT_V(8); PG8_WAIT_L(0); PG8_BAR; PG8_MMA(1, 0, At, B0); PG8_MMA(1, 1, At, B1); PG8_BAR; PG8_SCHED;
            PG8_LDB(B0, 1, 0); PG8_LDB(B1, 1, 1); PG8_SCHED; PG8_LDA(At, 1, 0);
            if constexpr (GATHER) PG8_STAGE_GA(PG8_SA(0, 1), kb2, 1); else PG8_STAGE(PG8_SA(0, 1), a2 + hstep, voffA);
            PG8_WAIT_V(8); PG8_WAIT_L(0); PG8_BAR; PG8_MMA(0, 0, At, B0); PG8_MMA(0, 1, At, B1); PG8_BAR; PG8_SCHED;
            PG8_LDA(At, 1, 1); PG8_STAGE(PG8_SB(1, 0), b3, voffB); PG8_STAGE(PG8_SB(1, 1), b3 + hstep, voffB);
            if constexpr (GATHER) PG8_STAGE_GA(PG8_SA(1, 0), kb2 + kstep, 0); else PG8_STAGE(PG8_SA(1, 0), a3, voffA);
            PG8_WAIT_V(8); PG8_WAIT_L(0); PG8_BAR; PG8_MMA(1, 0, At, B0); PG8_MMA(1, 1, At, B1); PG8_BAR; PG8_SCHED;
            } else {
            PG8_LDB(B0, 0, 0); PG8_SCHED; PG8_LDA(At, 0, 0); PG8_STAGE(PG8_SA(1, 1), a1 + hstep, voffA);
            PG8_WAIT_L(8); PG8_BAR; PG8_WAIT_L(0); PG8_MMA(0, 0, At, B0); PG8_BAR; PG8_SCHED;
            PG8_LDB(B1, 0, 1); PG8_STAGE(PG8_SB(0, 0), b2, voffB);
            PG8_BAR; PG8_WAIT_L(0); PG8_MMA(0, 1, At, B1); PG8_BAR;
            PG8_LDA(At, 0, 1); PG8_STAGE(PG8_SA(0, 0), a2, voffA);
            PG8_BAR; PG8_WAIT_L(0); PG8_MMA(1, 0, At, B0); PG8_BAR; PG8_SCHED;
            PG8_STAGE(PG8_SB(0, 1), b2 + hstep, voffB);
            PG8_WAIT_V(6); PG8_BAR; PG8_MMA(1, 1, At, B1); PG8_BAR;
            PG8_LDB(B0, 1, 0); PG8_SCHED; PG8_LDA(At, 1, 0); PG8_STAGE(PG8_SA(0, 1), a2 + hstep, voffA);
            PG8_WAIT_L(8); PG8_BAR; PG8_WAIT_L(0); PG8_MMA(0, 0, At, B0); PG8_BAR; PG8_SCHED;
            PG8_LDB(B1, 1, 1); PG8_STAGE(PG8_SB(1, 0), b3, voffB);
            PG8_BAR; PG8_WAIT_L(0); PG8_MMA(0, 1, At, B1); PG8_BAR;
            PG8_LDA(At, 1, 1); PG8_STAGE(PG8_SA(1, 0), a3, voffA);
            PG8_BAR; PG8_WAIT_L(0); PG8_MMA(1, 0, At, B0); PG8_BAR; PG8_SCHED;
            PG8_STAGE(PG8_SB(1, 1), b3 + hstep, voffB);
            PG8_WAIT_V(6); PG8_BAR; PG8_MMA(1, 1, At, B1); PG8_BAR;
            }
        }
        if constexpr (ALIGN_EPI) { if (wr == 0) PG8_BAR; }
        if constexpr (!Epi::AFTER_DRAIN) { int fr_ = fr, fq_ = fq; asm volatile("" : "+v"(fr_), "+v"(fq_));
            E(acc, cur, wr, wc, fr_, fq_); S.done(cur); }
        if (!has_next) break;
#pragma unroll
        for (int a = 0; a < 2; ++a)
#pragma unroll
            for (int b = 0; b < 2; ++b)
#pragma unroll
                for (int m = 0; m < 4; ++m)
#pragma unroll
                    for (int n = 0; n < 2; ++n) acc[a][b][m][n] = (f32x4){0.f, 0.f, 0.f, 0.f};
        cur = nxt; cA = nA; cB = nB; ++ui;
        if constexpr (ALIGN_EPI) { if (wr == 1) PG8_BAR; }
    }
    PG8_WAIT_V(0);
    if constexpr (!ALIGN_EPI) { if (wr == 0) PG8_BAR; }
    PG8_BAR;
    if constexpr (Epi::AFTER_DRAIN) { E.fused(acc, cur, wr, wc, fr, fq, lds, wid, lane); S.done(cur); }
#undef PG8_SA
#undef PG8_SB
#undef PG8_STAGE
#undef PG8_STAGE_GA
#undef PG8_GOFF
#undef PG8_LDA
#undef PG8_LDB
#undef PG8_MMA
#undef PG8_WAIT_V
#undef PG8_WAIT_L
#undef PG8_BAR
#undef PG8_SCHED
}
}
typedef short v4i16_t __attribute__((ext_vector_type(4)));
#define GAS __attribute__((address_space(1)))
#define LAS __attribute__((address_space(3)))
typedef unsigned short bf16;
typedef unsigned v4u __attribute__((ext_vector_type(4)));
typedef float f32x4 __attribute__((ext_vector_type(4)));
typedef short bf16x8 __attribute__((ext_vector_type(8)));
typedef GAS unsigned gu32;
typedef GAS unsigned long long gu64;
#define RLX_AGENT __ATOMIC_RELAXED, __HIP_MEMORY_SCOPE_AGENT
#define LDS_WAIT() asm volatile("s_waitcnt lgkmcnt(0)" ::: "memory")
#define VM_WAIT() asm volatile("s_waitcnt vmcnt(0)" ::: "memory")
__device__ __forceinline__ unsigned long long rt() { return __builtin_amdgcn_s_memrealtime(); }
__device__ __forceinline__ unsigned f2bf(float f) { unsigned u = __builtin_bit_cast(unsigned, f); return (u + 0x7fffu + ((u >> 16) & 1u)) >> 16; }
typedef float f32x2_t_ __attribute__((ext_vector_type(2))); typedef __bf16 bf16x2_t_ __attribute__((ext_vector_type(2)));
__device__ __forceinline__ unsigned pk2(float lo, float hi) { const f32x2_t_ v = {lo, hi}; return __builtin_bit_cast(unsigned, __builtin_convertvector(v, bf16x2_t_)); }

#define XB_TMO      128
#define XB_XCNT(j)  (256  + 64 * (j))
#define XB_XSUB(j)  (1280 + 64 * (j))
#define XB_XGEN(j)  (2304 + 64 * (j))
#define XB_TOP      3328
#define XB_TOPGEN   3392
#define XCD_BAR_WORDS 3456
#define XB_SPIN_CAP (1u << 18)

__device__ __forceinline__ unsigned xb_ld(unsigned* p)              { return __hip_atomic_load(p, __ATOMIC_RELAXED, __HIP_MEMORY_SCOPE_AGENT); }
__device__ __forceinline__ unsigned xb_add(unsigned* p, unsigned v) { return __hip_atomic_fetch_add(p, v, __ATOMIC_RELAXED, __HIP_MEMORY_SCOPE_AGENT); }
__device__ __forceinline__ unsigned xb_xcc_id() { return (unsigned)__builtin_amdgcn_s_getreg((3 << 11) | 20) & 0xFu; }
#define XB_SPIN(cond, bar) do { unsigned _sp = 0; while (cond) { __builtin_amdgcn_s_sleep(1); \
    if ((++_sp & 255u) == 0u) { if (xb_ld(&(bar)[XB_TMO])) break; if (_sp > XB_SPIN_CAP) { atomicAdd(&(bar)[XB_TMO], 1u); break; } } } } while (0)

struct XcdBarrier {
    unsigned* bar; unsigned x;
    volatile LAS unsigned* st;
};

__device__ __forceinline__ XcdBarrier xcd_barrier_post(unsigned* bar, volatile LAS unsigned* st) {
    XcdBarrier b; b.bar = bar; b.x = xb_xcc_id(); b.st = st;
    if (threadIdx.x == 0) (void)xb_add(&bar[XB_XCNT(b.x)], 1u);
    return b;
}
__device__ __forceinline__ void xcd_barrier_complete(unsigned* bar, unsigned x, unsigned& nloc, unsigned& nx) {
    const unsigned G = gridDim.x * gridDim.y * gridDim.z;
    unsigned sum, cnt, mine, sp = 0u;
    for (;;) {
        sum = 0u; cnt = 0u; mine = 0u;
#pragma unroll
        for (unsigned j = 0; j < 16; ++j) { const unsigned c = xb_ld(&bar[XB_XCNT(j)]); sum += c; cnt += (c > 0u) ? 1u : 0u; mine = (j == x) ? c : mine; }
        if (sum == G) break;
        __builtin_amdgcn_s_sleep(1);
        if ((++sp & 255u) == 0u) { if (xb_ld(&bar[XB_TMO])) break; if (sp > XB_SPIN_CAP) { atomicAdd(&bar[XB_TMO], 1u); break; } }
    }
    nloc = mine > 0u ? mine : 1u; nx = cnt > 0u ? cnt : 1u;
}

__device__ __forceinline__ void xcd_barrier(const XcdBarrier& b, const bool lead) {
    asm volatile("s_waitcnt vmcnt(0)" ::: "memory");
    __syncthreads();
    if (lead) {
        unsigned* bar = b.bar;
        __builtin_amdgcn_s_waitcnt(0);
        unsigned nloc = b.st[0], nx = b.st[1];
        if (nloc == 0u) { xcd_barrier_complete(bar, b.x, nloc, nx); b.st[0] = nloc; b.st[1] = nx; }
        const unsigned old = xb_add(&bar[XB_XSUB(b.x)], 1u);
        const unsigned gen = old / nloc;
        if (old + 1u == (gen + 1u) * nloc) {
            __builtin_amdgcn_fence(__ATOMIC_RELEASE, "agent");
            asm volatile("s_waitcnt vmcnt(0)" ::: "memory");
            const unsigned og = xb_add(&bar[XB_TOP], 1u);
            const unsigned tg = og / nx;
            if (og + 1u == (tg + 1u) * nx) xb_add(&bar[XB_TOPGEN], 1u);
            else XB_SPIN(xb_ld(&bar[XB_TOPGEN]) == tg, bar);
            __builtin_amdgcn_fence(__ATOMIC_ACQUIRE, "agent");
            xb_add(&bar[XB_XGEN(b.x)], 1u);
            asm volatile("s_waitcnt vmcnt(0)" ::: "memory");
        } else {
            XB_SPIN(xb_ld(&bar[XB_XGEN(b.x)]) == gen, bar);
            __builtin_amdgcn_fence(__ATOMIC_ACQUIRE, "agent");
            asm volatile("s_waitcnt vmcnt(0)" ::: "memory");
        }
    }
    __syncthreads();
}

constexpr int NB = 8, SEQ = 8192, T = NB * SEQ, D = 1024, DEPTH = 4;
constexpr int ZE = 2304, ZEW = 2816, ZO = 3072;
constexpr int NEXP = 32, PMAX = 2 * T + NEXP * 256;
constexpr float NORM_EPS = 1e-6f;
constexpr float LOG2E = 1.4426950408889634f, LN2 = 0.6931471805599453f;
constexpr int NWAVES = 8, NTHR = 512;

constexpr size_t MiB = 1u << 20;
constexpr size_t WS_CTL = 0, CTL_ZERO_BYTES = 1 * MiB;
constexpr size_t WS_MOD = 1 * MiB;
constexpr size_t WS_TOKE = 2 * MiB;
constexpr size_t WS_TOKR = WS_TOKE + 512 * 1024;
constexpr size_t WS_TOKW = WS_TOKR + 512 * 1024;
constexpr size_t WS_TOKD = WS_TOKW + 512 * 1024;
constexpr size_t WS_ROWTOK = 4 * MiB;
constexpr size_t WS_DEC = 6 * MiB;
constexpr size_t WS_LSE = 7 * MiB;
constexpr size_t WS_CS = 19 * MiB;
constexpr size_t WS_WRT = 23 * MiB;
constexpr size_t WS_WIN = 24 * MiB;
constexpr size_t WS_WOE = 35 * MiB;
constexpr size_t WS_WQKV = 39 * MiB;
constexpr size_t WS_WOO = 51 * MiB;
constexpr size_t WS_W13 = 56 * MiB;
constexpr size_t WS_W2 = 88 * MiB;
constexpr size_t WS_H = 104 * MiB;
constexpr size_t WS_X1 = 232 * MiB;
constexpr size_t WS_Z = 360 * MiB;
constexpr size_t WS_HID = WS_Z;
constexpr size_t WS_YS = 744 * MiB;
constexpr size_t WS_M = WS_YS;
constexpr size_t WS_M8 = WS_Z;
constexpr size_t WS_H8 = WS_YS + 128 * MiB;
constexpr size_t WS_EXPTOK = WS_YS + (size_t)PMAX * 1024 * 2;
constexpr int CAPE = T + 256;
constexpr size_t WS_XH = WS_EXPTOK + 9 * MiB;
constexpr size_t WS_END = WS_XH + (size_t)T * 1024 * 2;
static_assert(WS_EXPTOK + (size_t)NEXP * CAPE * 4 <= WS_XH, "token lists");
static_assert(WS_H8 + (size_t)T * 1024 <= WS_EXPTOK && WS_M + (size_t)T * 1024 * 2 <= WS_H8, "h2 rows inside the ys region");
static_assert(WS_Z + (size_t)T * ZO * 2 <= WS_YS && WS_HID + (size_t)PMAX * 512 * 2 <= WS_YS && WS_END <= 1160 * MiB, "d_ws map");
constexpr int CW_CNT = 64;
constexpr int CW_BAR = 4096;

constexpr int LDS_BYTES = 152 * 1024;
constexpr int LDS_CSROWS = 128 * 1024;
constexpr int LDS_TAB = 148 * 1024;
constexpr int LDS_MISC = 150 * 1024;
constexpr int LDS_PHASE_MAX = 148 * 1024;

typedef short s16x4 __attribute__((ext_vector_type(4)));
typedef float f32x2 __attribute__((ext_vector_type(2)));
typedef unsigned v2u __attribute__((ext_vector_type(2)));
struct Frame {
    LAS unsigned char* lds;
    gu32* ctl;
    int tid, lane, wave, vcu, G;
    float* out; unsigned char* ws;
};
__device__ __forceinline__ const void* inptr_raw(int k) {
    const __attribute__((address_space(1))) void* p; const void* tab = (const void*)__builtin_amdgcn_kernarg_segment_ptr();
    asm volatile("s_load_dwordx2 %0, %1, %2\n\ts_waitcnt lgkmcnt(0)" : "=s"(p) : "s"(tab), "i"(k * 8) : "memory");
    return (const void*)p;
}
#define INF(k) ((const float*)inptr_raw(k))
enum { I_X = 0, I_C = 1, I_POS = 2, I_ADAW = 3, I_ADAB = 4, I_N1G = 5, I_N2G = 6, I_EWIN = 7, I_EWG2 = 8, I_EBG = 9, I_EGNG = 10, I_ECW = 11, I_ECB = 12, I_ELNG = 13, I_ELNB = 14,
       I_EWOUT = 15, I_OWQKV = 16, I_OWOUT = 17, I_MWGRP = 18, I_MBGRP = 19, I_MWRT = 20, I_MBRT = 21, I_MW1 = 22, I_MW3 = 23, I_MW2 = 24, I_FNG = 25 };

__device__ __forceinline__ float bf2f(unsigned h) { return __builtin_bit_cast(float, h << 16); }
__device__ __forceinline__ float bflo(unsigned w) { return __builtin_bit_cast(float, w << 16); }
__device__ __forceinline__ float bfhi(unsigned w) { return __builtin_bit_cast(float, w & 0xffff0000u); }
template <int X> __device__ __forceinline__ float swz_xor(float v) { return __builtin_bit_cast(float, __builtin_amdgcn_ds_swizzle(__builtin_bit_cast(int, v), (X << 10) | 0x1F)); }
typedef _Float16 h16x4 __attribute__((ext_vector_type(4)));
__device__ __forceinline__ f32x4 ldxh(const unsigned char* XH, size_t t, int c) { const v2u u = __builtin_nontemporal_load((const v2u*)(XH + (t * D + c) * 2)); return __builtin_convertvector(__builtin_bit_cast(h16x4, u), f32x4); }
__device__ __forceinline__ void stxh(unsigned char* XH, size_t t, int c, const f32x4 v) { __builtin_nontemporal_store(__builtin_bit_cast(v2u, __builtin_convertvector(v, h16x4)), (v2u*)(XH + (t * D + c) * 2)); }
__device__ __forceinline__ float rows4_max(float m) { const unsigned u = __builtin_bit_cast(unsigned, m);
    const auto r = __builtin_amdgcn_permlane16_swap(u, u, false, false); const float t = fmaxf(__builtin_bit_cast(float, (unsigned)r[0]), __builtin_bit_cast(float, (unsigned)r[1])); const unsigned v = __builtin_bit_cast(unsigned, t);
    const auto s = __builtin_amdgcn_permlane32_swap(v, v, false, false); return fmaxf(__builtin_bit_cast(float, (unsigned)s[0]), __builtin_bit_cast(float, (unsigned)s[1])); }
__device__ __forceinline__ float rows4_sum(float m) { const unsigned u = __builtin_bit_cast(unsigned, m);
    const auto r = __builtin_amdgcn_permlane16_swap(u, u, false, false); const float t = __builtin_bit_cast(float, (unsigned)r[0]) + __builtin_bit_cast(float, (unsigned)r[1]); const unsigned v = __builtin_bit_cast(unsigned, t);
    const auto s = __builtin_amdgcn_permlane32_swap(v, v, false, false); return __builtin_bit_cast(float, (unsigned)s[0]) + __builtin_bit_cast(float, (unsigned)s[1]); }
__device__ __forceinline__ float bperm_xor32(float v, int lane) { return __builtin_bit_cast(float, __builtin_amdgcn_ds_bpermute((lane ^ 32) << 2, __builtin_bit_cast(int, v))); }
__device__ __forceinline__ float fexp(float x) { return __builtin_amdgcn_exp2f(x * LOG2E); }
__device__ __forceinline__ float frcp(float x) { return __builtin_amdgcn_rcpf(x); }
__device__ __forceinline__ float fsilu(float x) { return x * frcp(1.0f + fexp(-x)); }
__device__ __forceinline__ float fsigmoid(float x) { return frcp(1.0f + fexp(-x)); }
__device__ __forceinline__ float flogsigmoid(float x) { return fminf(x, 0.f) - __builtin_amdgcn_logf(1.0f + fexp(-fabsf(x))) * LN2; }
__device__ __forceinline__ float row_sum16(float v) {
    v += __builtin_bit_cast(float, __builtin_amdgcn_update_dpp(0, __builtin_bit_cast(int, v), 0xB1, 0xF, 0xF, true));
    v += __builtin_bit_cast(float, __builtin_amdgcn_update_dpp(0, __builtin_bit_cast(int, v), 0x4E, 0xF, 0xF, true));
    v += __builtin_bit_cast(float, __builtin_amdgcn_update_dpp(0, __builtin_bit_cast(int, v), 0x141, 0xF, 0xF, true));
    v += __builtin_bit_cast(float, __builtin_amdgcn_update_dpp(0, __builtin_bit_cast(int, v), 0x140, 0xF, 0xF, true));
    return v;
}
__device__ __forceinline__ float wave_sum(float v) {
    v = row_sum16(v); const int x = __builtin_bit_cast(int, v);
    return (__builtin_bit_cast(float, __builtin_amdgcn_readlane(x, 0)) + __builtin_bit_cast(float, __builtin_amdgcn_readlane(x, 16))) +
           (__builtin_bit_cast(float, __builtin_amdgcn_readlane(x, 32)) + __builtin_bit_cast(float, __builtin_amdgcn_readlane(x, 48)));
}
__device__ __forceinline__ void unpack8(const v4u w, float (&o)[8]) { o[0] = bflo(w.x); o[1] = bfhi(w.x); o[2] = bflo(w.y); o[3] = bfhi(w.y); o[4] = bflo(w.z); o[5] = bfhi(w.z); o[6] = bflo(w.w); o[7] = bfhi(w.w); }
__device__ __forceinline__ v4u pack8(const float (&o)[8]) { v4u w; w.x = pk2(o[0], o[1]); w.y = pk2(o[2], o[3]); w.z = pk2(o[4], o[5]); w.w = pk2(o[6], o[7]); return w; }

__device__ __forceinline__ unsigned pk4_fp8(float a, float b, float c, float d) {
    a = __builtin_amdgcn_fmed3f(a, -448.f, 448.f); b = __builtin_amdgcn_fmed3f(b, -448.f, 448.f); c = __builtin_amdgcn_fmed3f(c, -448.f, 448.f); d = __builtin_amdgcn_fmed3f(d, -448.f, 448.f);
    int w = 0; w = __builtin_amdgcn_cvt_pk_fp8_f32(a, b, w, false); w = __builtin_amdgcn_cvt_pk_fp8_f32(c, d, w, true); return (unsigned)w; }
constexpr float W8_SCALE = 32.0f;

__device__ __forceinline__ void transpose_item(const float* W, int ldw, int coff, int K, bf16* WT, int mode, int row_off, LAS float* scr, int kb, int nb, int lane) {
    const int k0 = 64 * kb, n0 = 32 * nb;
    float tv[32];
#pragma unroll
    for (int i = 0; i < 32; ++i) tv[i] = __builtin_nontemporal_load(W + (size_t)(k0 + 2 * i + (lane >> 5)) * ldw + coff + n0 + (lane & 31));
#pragma unroll
    for (int i = 0; i < 32; ++i) scr[(2 * i + (lane >> 5)) * 33 + (lane & 31)] = tv[i];
    LDS_WAIT(); asm volatile("" ::: "memory");
    const int c = lane & 7;
#pragma unroll
    for (int j = 0; j < 4; ++j) { const int n = (lane >> 3) + 8 * j; const LAS float* s = scr + (8 * c) * 33 + n;
        v4u o; o.x = pk2(s[0 * 33], s[1 * 33]); o.y = pk2(s[2 * 33], s[3 * 33]); o.z = pk2(s[4 * 33], s[5 * 33]); o.w = pk2(s[6 * 33], s[7 * 33]);
        const int nn = n0 + n;
        if (mode == 3 || mode == 5) {
            v2u o8; o8.x = pk4_fp8(s[0 * 33] * W8_SCALE, s[1 * 33] * W8_SCALE, s[2 * 33] * W8_SCALE, s[3 * 33] * W8_SCALE); o8.y = pk4_fp8(s[4 * 33] * W8_SCALE, s[5 * 33] * W8_SCALE, s[6 * 33] * W8_SCALE, s[7 * 33] * W8_SCALE);
            int nr_ = nn; if (mode == 5 && nn >= 2048) { const int dm_ = nn & 63; nr_ = (nn & ~63) + 16 * ((dm_ >> 2) & 3) + 4 * (dm_ >> 4) + (dm_ & 3); }
            *(v2u*)((unsigned char*)WT + (size_t)(row_off + nr_) * K + k0 + 8 * c) = o8;
        } else {
        const int drow = (mode == 0) ? (row_off + nn) : (mode == 4) ? (row_off + (((nn & 511) >> 7) << 8) + (nn & 127) + ((nn >> 9) << 7))
                                                       : (((nn >> 7) << 8) + (nn & 127) + (mode == 2 ? 128 : 0));
        *(v4u*)(WT + (size_t)drow * K + k0 + 8 * c) = o; } }
    LDS_WAIT(); asm volatile("" ::: "memory");
}

__device__ __forceinline__ void convert_moe(Frame& F, int layer) {
    const int tid = F.tid, w = F.wave, lane = F.lane;
    unsigned char* W13 = F.ws + WS_W13; unsigned char* W2 = F.ws + WS_W2;
    const float* m_w1 = INF(I_MW1); const float* m_w3 = INF(I_MW3); const float* m_w2 = INF(I_MW2);
    LAS unsigned* TL = (LAS unsigned*)(F.lds + 0);
    for (int it = blockIdx.x; it < NEXP * 48; it += F.G) {
        const int e = it / 48, r = it % 48, which = r >> 4, q = r & 15;
        const size_t eoff = (size_t)(layer * NEXP + e) * (1024 * 512);
        const float* src; int ldw, k0, n0; int mode;
        if (which == 0)      { src = m_w1 + eoff; ldw = 512; k0 = 64 * q; n0 = 0; mode = 1; }
        else if (which == 1) { src = m_w3 + eoff; ldw = 512; k0 = 64 * q; n0 = 0; mode = 2; }
        else                 { src = m_w2 + eoff; ldw = 1024; k0 = 64 * (q >> 1); n0 = 512 * (q & 1); mode = 0; }
        float va[4][8], vb[4][8];
#pragma unroll
        for (int pp = 0; pp < 4; ++pp) { const float* r0 = src + (size_t)(k0 + 2 * (4 * w + pp)) * ldw + n0 + lane;
#pragma unroll
            for (int m = 0; m < 8; ++m) { va[pp][m] = __builtin_nontemporal_load(r0 + 64 * m); vb[pp][m] = __builtin_nontemporal_load(r0 + ldw + 64 * m); } }
        __syncthreads();
#pragma unroll
        for (int qd = 0; qd < 2; ++qd)
#pragma unroll
            for (int m = 0; m < 8; ++m) TL[(lane + 64 * m) * 18 + 2 * w + qd] = pk4_fp8(va[2 * qd][m] * W8_SCALE, vb[2 * qd][m] * W8_SCALE, va[2 * qd + 1][m] * W8_SCALE, vb[2 * qd + 1][m] * W8_SCALE);
        __syncthreads();
#pragma unroll
        for (int i = 0; i < 4; ++i) { const int id = tid + NTHR * i, n = id >> 2, q4 = id & 3;
            const v2u lo = *(const LAS v2u*)(TL + n * 18 + 4 * q4), hi = *(const LAS v2u*)(TL + n * 18 + 4 * q4 + 2);
            if (mode == 0) { const int cc_ = n0 + n, cl_ = cc_ & 255;
                const int r_ = (cc_ & ~255) + 128 * ((cl_ >> 3) & 1) + 32 * (cl_ >> 6) + 8 * ((cl_ >> 4) & 3) + (cl_ & 7);
                *(v4u*)(W2 + (size_t)e * 1024 * 512 + (size_t)r_ * 512 + k0 + 16 * q4) = (v4u){lo.x, lo.y, hi.x, hi.y}; }
            else { const int drow = ((n >> 7) << 8) + (n & 127) + (mode == 2 ? 128 : 0);
                *(v4u*)(W13 + (size_t)e * 1024 * 1024 + (size_t)drow * 1024 + k0 + 16 * q4) = (v4u){lo.x, lo.y, hi.x, hi.y}; } }
    }
    __syncthreads();
}

__device__ __forceinline__ void phase_prologue(Frame& F) {
    LAS float* scr = (LAS float*)(F.lds + F.wave * 16384);
    const int gw = blockIdx.x * NWAVES + F.wave, NGW = F.G * NWAVES;
    const int gt = blockIdx.x * NTHR + F.tid, NGT = F.G * NTHR;
    const float* e_win = INF(I_EWIN);
    {
        const float* e_wout = INF(I_EWOUT); const float* o_wqkv = INF(I_OWQKV); const float* o_wout = INF(I_OWOUT); const float* e_wg2 = INF(I_EWG2);
        bf16* WIN = (bf16*)(F.ws + WS_WIN); bf16* WOE = (bf16*)(F.ws + WS_WOE); bf16* WQKV = (bf16*)(F.ws + WS_WQKV); bf16* WOO = (bf16*)(F.ws + WS_WOO);
        constexpr int I_A = 16 * 48, I_U = 16 * 32, I_O = 16 * 32, I_Q = 16 * 96, PER = I_A + I_U + I_O + I_Q + I_O;
        for (int it = gw; it < 2 * PER; it += NGW) {
            const int i = it / PER; int r = it % PER;
            if (r < I_A) { transpose_item(e_win + (size_t)i * 1024 * 2576, 2576, 0, 1024, WIN + (size_t)i * ZEW * 1024, 0, 0, scr, r / 48, r % 48, F.lane); continue; } r -= I_A;
            if (r < I_U) { transpose_item(e_win + (size_t)i * 1024 * 2576, 2576, 1552, 1024, WIN + (size_t)i * ZEW * 1024, 4, 1792, scr, r / 32, r % 32, F.lane); continue; } r -= I_U;
            if (r < I_O) { transpose_item(e_wout + (size_t)i * 1024 * 1024, 1024, 0, 1024, WOE + (size_t)i * 1024 * 1024, 0, 0, scr, r / 32, r % 32, F.lane); continue; } r -= I_O;
            if (r < I_Q) { transpose_item(o_wqkv + (size_t)i * 1024 * 3072, 3072, 0, 1024, (bf16*)((unsigned char*)WQKV + (size_t)i * 3072 * 1024), 5, 0, scr, r / 96, r % 96, F.lane); continue; } r -= I_Q;
            transpose_item(o_wout + (size_t)i * 1024 * 1024, 1024, 0, 1024, (bf16*)((unsigned char*)WOO + (size_t)i * 1024 * 1024), 3, 0, scr, r / 32, r % 32, F.lane);
        }
        for (int it = gt; it < 2 * 256 * 128; it += NGT) {
            const int i = it >> 15, c = (it >> 7) & 255, kg = it & 127;
            const float* win = e_win + (size_t)i * 1024 * 2576 + 1536; const float* wg = e_wg2 + (size_t)i * 16 * 256 + c;
            float g[16];
#pragma unroll
            for (int r = 0; r < 16; ++r) g[r] = wg[r * 256];
            float o[8];
#pragma unroll
            for (int kk = 0; kk < 8; ++kk) { const float* wr = win + (size_t)(kg * 8 + kk) * 2576; float s = 0.f;
#pragma unroll
                for (int r = 0; r < 16; ++r) s += wr[r] * g[r];
                o[kk] = s; }
            v4u w; w.x = pk2(o[0], o[1]); w.y = pk2(o[2], o[3]); w.z = pk2(o[4], o[5]); w.w = pk2(o[6], o[7]);
            *(v4u*)(WIN + (size_t)i * ZEW * 1024 + (size_t)(1536 + c) * 1024 + kg * 8) = w;
        }
    }
    {
        bf16* WR = (bf16*)(F.ws + WS_WRT); const float* m_wgrp = INF(I_MWGRP); const float* m_wrt = INF(I_MWRT);
        for (int it = gt; it < DEPTH * 48 * 128; it += NGT) {
            const int l = it / (48 * 128), r = it % (48 * 128), o = r >> 7, kg = r & 127;
            float v[8], lo[8];
#pragma unroll
            for (int kk = 0; kk < 8; ++kk) { const int k = kg * 8 + kk;
                v[kk] = (o < 4) ? m_wgrp[((size_t)l * 1024 + k) * 4 + o] : ((o < 36) ? m_wrt[((size_t)l * 1024 + k) * 32 + (o - 4)] : 0.f);
                lo[kk] = v[kk] - bf2f(f2bf(v[kk])); }
            *(v4u*)(WR + ((size_t)(l * 2 + 0) * 48 + o) * 1024 + kg * 8) = pack8(v);
            *(v4u*)(WR + ((size_t)(l * 2 + 1) * 48 + o) * 1024 + kg * 8) = pack8(lo);
        }
    }
    {
        float* CS = (float*)(F.ws + WS_CS); const int* pos = (const int*)inptr_raw(I_POS);
        for (int it = gt; it < T * 8; it += NGT) {
            const int t = it >> 3, i = it & 7;
            const double revs[8] = {0.15915494309189535, 0.03086376340470123, 0.005985185712713705, 0.001160663641240061, 0.00022507907903927653, 4.364795279280289e-05, 8.464330808241401e-06, 1.6414262627950345e-06};
            double rv = 0.0;
#pragma unroll
            for (int q = 0; q < 8; ++q) rv = (i == q) ? revs[q] : rv;
            const double a = (double)pos[t] * rv; const float fr = (float)(a - __builtin_rint(a));
            CS[(size_t)t * 16 + i] = __builtin_amdgcn_cosf(fr); CS[(size_t)t * 16 + 8 + i] = __builtin_amdgcn_sinf(fr);
        }
    }
    {
        float* MOD = (float*)(F.ws + WS_MOD); const float* cin = INF(I_C); const float* ada_w = INF(I_ADAW); const float* ada_b = INF(I_ADAB);
        LAS float* cond = (LAS float*)(F.lds + 0);
        LAS float* red = (LAS float*)(F.lds + 32768);
        __syncthreads();
        for (int i = F.tid; i < NB * 1024; i += NTHR) { const float v = cin[i]; cond[i] = v / (1.0f + expf(-v)); }
        __syncthreads();
        for (int it = blockIdx.x; it < DEPTH * 48; it += F.G) {
            const int l = it / 48, j0 = (it % 48) * 128;
            const float* W = ada_w + (size_t)l * 1024 * 6144 + j0 + 2 * F.lane;
            float a0[8], a1[8];
#pragma unroll
            for (int b = 0; b < 8; ++b) { a0[b] = 0.f; a1[b] = 0.f; }
            for (int kc = 0; kc < 8; ++kc) { const int kb = F.wave * 128 + kc * 16;
                f32x2 wv[16];
#pragma unroll
                for (int kk = 0; kk < 16; ++kk) wv[kk] = __builtin_nontemporal_load((const f32x2*)(W + (size_t)(kb + kk) * 6144));
#pragma unroll
                for (int kk = 0; kk < 16; ++kk)
#pragma unroll
                    for (int b = 0; b < 8; ++b) { const float cv = cond[b * 1024 + kb + kk]; a0[b] += cv * wv[kk].x; a1[b] += cv * wv[kk].y; }
            }
#pragma unroll
            for (int b = 0; b < 8; ++b) { red[(F.wave * 8 + b) * 128 + 2 * F.lane] = a0[b]; red[(F.wave * 8 + b) * 128 + 2 * F.lane + 1] = a1[b]; }
            __syncthreads();
            for (int o = F.tid; o < 8 * 128; o += NTHR) { const int b = o >> 7, j = o & 127; float s = 0.f;
#pragma unroll
                for (int w = 0; w < 8; ++w) s += red[(w * 8 + b) * 128 + j];
                MOD[((size_t)l * 8 + b) * 6144 + j0 + j] = s + ada_b[l * 6144 + j0 + j]; }
            __syncthreads();
        }
    }
}

__device__ __forceinline__ void build_tstart(Frame& F, int layer) {
    LAS int* ts = (LAS int*)(F.lds + LDS_TAB);
    __syncthreads();
    if (F.wave == 0) {
        const int lane = F.lane;
        const unsigned cn = (lane < NEXP) ? __hip_atomic_load(F.ctl + CW_CNT + layer * 32 + lane, RLX_AGENT) : 0u;
        const int tl = (int)((cn + 255u) >> 8);
        int v = tl;
        v += __builtin_amdgcn_update_dpp(0, v, 0x111, 0xF, 0xF, true);
        v += __builtin_amdgcn_update_dpp(0, v, 0x112, 0xF, 0xF, true);
        v += __builtin_amdgcn_update_dpp(0, v, 0x114, 0xF, 0xF, true);
        v += __builtin_amdgcn_update_dpp(0, v, 0x118, 0xF, 0xF, true);
        const int t0 = __builtin_amdgcn_readlane(v, 15);
        if (lane >= 16) v += t0;
        if (lane < NEXP) ts[lane] = v - tl;
        if (lane == NEXP - 1) ts[NEXP] = v; }
    __syncthreads();
}

__device__ __forceinline__ void phase_n1(Frame& F, int layer, const float probe_scale = 1.0f) {
    const int gw = blockIdx.x * NWAVES + F.wave; const int b = gw >> 8; const int lane = F.lane;
    const float* MOD = (const float*)(F.ws + WS_MOD);
    const bool fin = (layer == DEPTH);
    const float* fng = INF(I_FNG); const float* n1g = INF(I_N1G); const float* xin0 = INF(I_X);
    f32x4 A[4], Bv[4], G2[4];
#pragma unroll
    for (int j = 0; j < 4; ++j) { const int c = 256 * j + 4 * lane;
        if (fin) { A[j] = *(const f32x4*)(fng + c); Bv[j] = (f32x4){0.f, 0.f, 0.f, 0.f}; }
        else { const float* m = MOD + ((size_t)layer * 8 + b) * 6144; const f32x4 g = *(const f32x4*)(n1g + layer * 1024 + c), sc = *(const f32x4*)(m + 1024 + c);
            A[j] = g * (sc + 1.0f); Bv[j] = *(const f32x4*)(m + c); }
        G2[j] = (f32x4){0.f, 0.f, 0.f, 0.f};
        if (layer > 0) G2[j] = *(const f32x4*)(MOD + ((size_t)(layer - 1) * 8 + b) * 6144 + 5120 + c) * (probe_scale * 0.0625f); }
    const float* TW = (const float*)(F.ws + WS_TOKW);
    const unsigned char* YS8 = F.ws + WS_YS; bf16* H = (bf16*)(F.ws + WS_H); unsigned char* XH = F.ws + WS_XH;
    int dl = 0; float wl = 0.f;
    if (layer > 0) { build_tstart(F, layer - 1);
        const int* TE = (const int*)(F.ws + WS_TOKE); const int* TR = (const int*)(F.ws + WS_TOKR);
        dl = ((const LAS int*)(F.lds + LDS_TAB))[TE[(size_t)gw * 64 + lane]] * 256 + TR[(size_t)gw * 64 + lane]; wl = TW[(size_t)gw * 64 + lane]; }
    for (int r = 0; r < 32; r += 2) {
        f32x4 v[2][4]; unsigned y0[2][4], y1[2][4]; float w0[2], w1[2];
#pragma unroll
        for (int p = 0; p < 2; ++p) { const size_t t = (size_t)gw * 32 + r + p;
            if (layer == 0) {
#pragma unroll
                for (int j = 0; j < 4; ++j) v[p][j] = *(const f32x4*)(xin0 + t * D + 256 * j + 4 * lane);
            } else {
                const int d0 = __builtin_amdgcn_readlane(dl, 2 * (r + p)), d1 = __builtin_amdgcn_readlane(dl, 2 * (r + p) + 1); w0[p] = __builtin_bit_cast(float, __builtin_amdgcn_readlane(__builtin_bit_cast(int, wl), 2 * (r + p))); w1[p] = __builtin_bit_cast(float, __builtin_amdgcn_readlane(__builtin_bit_cast(int, wl), 2 * (r + p) + 1));
#pragma unroll
                for (int j = 0; j < 4; ++j) { const int c = 256 * j + 4 * lane;
                    v[p][j] = ldxh(XH, t, c); y0[p][j] = __builtin_nontemporal_load((const unsigned*)(YS8 + (size_t)d0 * D + c)); y1[p][j] = __builtin_nontemporal_load((const unsigned*)(YS8 + (size_t)d1 * D + c)); }
            } }
#pragma unroll
        for (int p = 0; p < 2; ++p) { const size_t t = (size_t)gw * 32 + r + p;
            if (layer > 0) {
#pragma unroll
                for (int j = 0; j < 4; ++j) { f32x4 y;
                    typedef float f32x2_ __attribute__((ext_vector_type(2)));
                    const f32x2_ a0 = __builtin_amdgcn_cvt_pk_f32_fp8((int)y0[p][j], false), a1 = __builtin_amdgcn_cvt_pk_f32_fp8((int)y0[p][j], true), b0 = __builtin_amdgcn_cvt_pk_f32_fp8((int)y1[p][j], false), b1 = __builtin_amdgcn_cvt_pk_f32_fp8((int)y1[p][j], true);
                    y.x = w0[p] * a0.x + w1[p] * b0.x; y.y = w0[p] * a0.y + w1[p] * b0.y; y.z = w0[p] * a1.x + w1[p] * b1.x; y.w = w0[p] * a1.y + w1[p] * b1.y;
                    v[p][j] = v[p][j] + G2[j] * y; }
                if (!fin) {
#pragma unroll
                    for (int j = 0; j < 4; ++j) stxh(XH, t, 256 * j + 4 * lane, v[p][j]);
                }
            }
            float ss = 0.f;
#pragma unroll
            for (int j = 0; j < 4; ++j) ss += (v[p][j].x * v[p][j].x + v[p][j].y * v[p][j].y) + (v[p][j].z * v[p][j].z + v[p][j].w * v[p][j].w);
            const float rstd = __builtin_amdgcn_rsqf(wave_sum(ss) * (1.0f / D) + NORM_EPS);
            if (fin) {
#pragma unroll
                for (int j = 0; j < 4; ++j) __builtin_nontemporal_store(v[p][j] * rstd * A[j], (f32x4*)(F.out + t * D + 256 * j + 4 * lane));
            } else {
#pragma unroll
                for (int j = 0; j < 4; ++j) { const f32x4 hh = v[p][j] * rstd * A[j] + Bv[j];
                    if (layer & 1) *(unsigned*)((unsigned char*)H + t * D + 256 * j + 4 * lane) = pk4_fp8(hh.x, hh.y, hh.z, hh.w);
                    else { v2u o; o.x = pk2(hh.x, hh.y); o.y = pk2(hh.z, hh.w); *(v2u*)(H + t * D + 256 * j + 4 * lane) = o; } }
            }
        }
    }
}

constexpr int N2_HH = 0, N2_HL = 66048, N2_PART = 0  , N2_LG = 132096, N2_LE = 138240, N2_LR = 140288, N2_LCNT = 142336, N2_LBASE = 142464;
__device__ __forceinline__ void phase_n2(Frame& F, int layer, const bool probe_dry = false) {
    const int gw = blockIdx.x * NWAVES + F.wave; const int b = gw >> 8; const int lane = F.lane, w = F.wave, tid = F.tid, c = lane & 15, g = lane >> 4;
    const float* MOD = (const float*)(F.ws + WS_MOD) + ((size_t)layer * 8 + b) * 6144;
    LAS float* part = (LAS float*)(F.lds + N2_PART);
    LAS float* lg = (LAS float*)(F.lds + N2_LG);
    LAS int* le = (LAS int*)(F.lds + N2_LE);
    LAS int* lr = (LAS int*)(F.lds + N2_LR);
    LAS int* lcnt = (LAS int*)(F.lds + N2_LCNT);
    LAS int* lbase = (LAS int*)(F.lds + N2_LBASE);
    __syncthreads();
    if (tid < 32) lcnt[tid] = 0;
    const float* n2g = INF(I_N2G); const float* m_bgrp = INF(I_MBGRP); const float* m_brt = INF(I_MBRT);
    f32x4 A[4], Bv[4], G1[4];
#pragma unroll
    for (int j = 0; j < 4; ++j) { const int cc = 256 * j + 4 * lane;
        const f32x4 gg = *(const f32x4*)(n2g + layer * 1024 + cc), sc = *(const f32x4*)(MOD + 4096 + cc);
        A[j] = gg * (sc + 1.0f); Bv[j] = *(const f32x4*)(MOD + 3072 + cc); G1[j] = *(const f32x4*)(MOD + 2048 + cc) * (probe_dry ? 0.0f : 1.0f); }
    bf16x8 wh[4][3], wl[4][3];
    { const bf16* WRH = (const bf16*)(F.ws + WS_WRT) + (size_t)layer * 2 * 48 * 1024; const bf16* WRL = WRH + 48 * 1024;
#pragma unroll
        for (int s = 0; s < 4; ++s)
#pragma unroll
            for (int nt = 0; nt < 3; ++nt) { const size_t o = (size_t)(16 * nt + c) * 1024 + 128 * w + 32 * s + 8 * g;
                wh[s][nt] = *(const bf16x8*)(WRH + o); wl[s][nt] = *(const bf16x8*)(WRL + o); } }
    const float* xin = INF(I_X); unsigned char* XH = F.ws + WS_XH;
    const bf16* Y = (const bf16*)(F.ws + WS_H); bf16* H = (bf16*)(F.ws + WS_H);
    float* TW = (float*)(F.ws + WS_TOKW); unsigned char* H8 = F.ws + WS_H8;
    for (int rg = 0; rg < 8; ++rg) {
        {
        v2u xr[4][4], yv[4][4];
#pragma unroll
        for (int q2 = 0; q2 < 4; ++q2) { const size_t t = (size_t)gw * 32 + rg * 4 + q2;
#pragma unroll
            for (int j = 0; j < 4; ++j) { const int cc = 256 * j + 4 * lane;
                xr[q2][j] = (layer == 0) ? __builtin_bit_cast(v2u, __builtin_convertvector(__builtin_nontemporal_load((const f32x4*)(xin + t * D + cc)), h16x4)) : __builtin_nontemporal_load((const v2u*)(XH + (t * D + cc) * 2));
                yv[q2][j] = *(const v2u*)(Y + t * D + cc); } }
#pragma unroll
        for (int q2 = 0; q2 < 4; ++q2) {
            const int q = q2;
            const size_t t = (size_t)gw * 32 + rg * 4 + q;
            f32x4 v[4]; float ss = 0.f;
#pragma unroll
            for (int j = 0; j < 4; ++j) { const int cc = 256 * j + 4 * lane;
                f32x4 y; y.x = bflo(yv[q2][j].x); y.y = bfhi(yv[q2][j].x); y.z = bflo(yv[q2][j].y); y.w = bfhi(yv[q2][j].y);
                v[j] = __builtin_convertvector(__builtin_bit_cast(h16x4, xr[q2][j]), f32x4) + G1[j] * y;
                stxh(XH, t, cc, v[j]);
                ss += (v[j].x * v[j].x + v[j].y * v[j].y) + (v[j].z * v[j].z + v[j].w * v[j].w); }
            const float rstd = __builtin_amdgcn_rsqf(wave_sum(ss) * (1.0f / D) + NORM_EPS);
#pragma unroll
            for (int j = 0; j < 4; ++j) { const f32x4 hv = v[j] * rstd * A[j] + Bv[j];
                v2u hi; hi.x = pk2(hv.x, hv.y); hi.y = pk2(hv.z, hv.w);
                if (!probe_dry) *(unsigned*)(H8 + t * D + 256 * j + 4 * lane) = pk4_fp8(hv.x, hv.y, hv.z, hv.w);
                v2u lo; lo.x = pk2(hv.x - bflo(hi.x), hv.y - bfhi(hi.x)); lo.y = pk2(hv.z - bflo(hi.y), hv.w - bfhi(hi.y));
                *(LAS v2u*)(F.lds + N2_HH + (w * 4 + q) * 2064 + (256 * j + 4 * lane) * 2) = hi;
                *(LAS v2u*)(F.lds + N2_HL + (w * 4 + q) * 2064 + (256 * j + 4 * lane) * 2) = lo; }
        }
        }
        __syncthreads();
        f32x4 acc[2][3];
#pragma unroll
        for (int rt = 0; rt < 2; ++rt)
#pragma unroll
            for (int nt = 0; nt < 3; ++nt) acc[rt][nt] = (f32x4){0.f, 0.f, 0.f, 0.f};
#pragma unroll
        for (int s = 0; s < 4; ++s)
#pragma unroll
            for (int rt = 0; rt < 2; ++rt) { const int off = (16 * rt + c) * 2064 + (128 * w + 32 * s + 8 * g) * 2;
                const bf16x8 ah = *(const LAS bf16x8*)(F.lds + N2_HH + off), al = *(const LAS bf16x8*)(F.lds + N2_HL + off);
#pragma unroll
                for (int nt = 0; nt < 3; ++nt) { f32x4 a = acc[rt][nt];
                    a = __builtin_amdgcn_mfma_f32_16x16x32_bf16(ah, wh[s][nt], a, 0, 0, 0); a = __builtin_amdgcn_mfma_f32_16x16x32_bf16(ah, wl[s][nt], a, 0, 0, 0);
                    a = __builtin_amdgcn_mfma_f32_16x16x32_bf16(al, wh[s][nt], a, 0, 0, 0); acc[rt][nt] = a; } }
        __syncthreads();
#pragma unroll
        for (int rt = 0; rt < 2; ++rt)
#pragma unroll
            for (int nt = 0; nt < 3; ++nt)
#pragma unroll
                for (int r = 0; r < 4; ++r) part[(w * 32 + 16 * rt + 4 * g + r) * 48 + 16 * nt + c] = acc[rt][nt][r];
        __syncthreads();
#pragma unroll
        for (int i3 = 0; i3 < 3; ++i3) { const int id = tid + NTHR * i3; float s = 0.f;
#pragma unroll
            for (int ww = 0; ww < 8; ++ww) s += part[ww * 1536 + id];
            lg[id] = s; }
        __syncthreads();
        if (tid < 32) {
            const LAS float* L = lg + tid * 48;
            const float* bg = m_bgrp + layer * 4; const float* br = m_brt + layer * 32;
            float gl[4];
#pragma unroll
            for (int i = 0; i < 4; ++i) gl[i] = L[i] + bg[i];
            int gi = 0; float gm = gl[0];
#pragma unroll
            for (int i = 1; i < 4; ++i) if (gl[i] > gm) { gm = gl[i]; gi = i; }
            float gs = 0.f;
#pragma unroll
            for (int i = 0; i < 4; ++i) gs += expf(gl[i] - gm);
            const float gwt = 1.0f / gs;
            float ev[8];
#pragma unroll
            for (int i = 0; i < 8; ++i) ev[i] = L[4 + gi * 8 + i] + br[gi * 8 + i];
            int i1 = 0; float v1 = ev[0];
#pragma unroll
            for (int i = 1; i < 8; ++i) if (ev[i] > v1) { v1 = ev[i]; i1 = i; }
            int i2 = (i1 == 0) ? 1 : 0; float v2 = -3.0e38f;
#pragma unroll
            for (int i = 0; i < 8; ++i) if (i != i1 && ev[i] > v2) { v2 = ev[i]; i2 = i; }
            const float ex = expf(v2 - v1); const float w1 = 1.0f / (1.0f + ex), w2 = ex * w1;
            const int e0 = gi * 8 + i1, e1 = gi * 8 + i2;
            const int lrow = (tid >> 2) * 32 + rg * 4 + (tid & 3);
            le[2 * lrow] = e0; le[2 * lrow + 1] = e1;
            lr[2 * lrow] = __hip_atomic_fetch_add(&lcnt[e0], 1, __ATOMIC_RELAXED, __HIP_MEMORY_SCOPE_WORKGROUP); lr[2 * lrow + 1] = __hip_atomic_fetch_add(&lcnt[e1], 1, __ATOMIC_RELAXED, __HIP_MEMORY_SCOPE_WORKGROUP);
            const size_t t = (size_t)(blockIdx.x * NWAVES + (tid >> 2)) * 32 + rg * 4 + (tid & 3);
            TW[2 * t] = w1 * gwt; TW[2 * t + 1] = w2 * gwt;
        }
    }
    __syncthreads();
    if (probe_dry) return;
    if (tid < 32) lbase[tid] = (int)atomicAdd((unsigned*)(F.ctl + CW_CNT + layer * 32 + tid), (unsigned)lcnt[tid]);
    __syncthreads();
    {
        int* TE = (int*)(F.ws + WS_TOKE); int* TR = (int*)(F.ws + WS_TOKR);
        const int a = tid;
        const int lrow = a >> 1; const size_t t = (size_t)(blockIdx.x * NWAVES + (lrow >> 5)) * 32 + (lrow & 31);
        const int e = le[a];
        const int rank = lbase[e] + lr[a];
        TE[2 * t + (a & 1)] = e; TR[2 * t + (a & 1)] = rank;
        ((int*)(F.ws + WS_EXPTOK))[(size_t)e * CAPE + rank] = (int)t;
    }
}

__device__ __forceinline__ s16x4 vtr(const LAS unsigned char* p) { return __builtin_bit_cast(s16x4, __builtin_amdgcn_ds_read_tr16_b64_v4i16((LAS v4i16_t*)p)); }
constexpr int GL_LA = 0, GL_TOT = 16640, GL_QT = 18688, GL_KT = 28928, GL_VT = 39168, GL_ST = 57600, GL_SSQ = 76032;
struct GlaRaw { v4u k, gp, q; v4u v[2]; v4u s[2]; };
template <bool OUT> __device__ __forceinline__ void gla_load(Frame& F, const bf16* Z, const bf16* KV, int u, size_t t0, int h, GlaRaw& R) {
    const int tid = F.tid, j = F.lane, w = F.wave;
    const bf16* zr = Z + (t0 + j) * ZE;
    R.k = *(const v4u*)(zr + 256 + h * 64 + 8 * w); R.gp = *(const v4u*)(zr + 1536 + h * 64 + 8 * w);
    R.q = (v4u){0u, 0u, 0u, 0u}; if (OUT) R.q = *(const v4u*)(zr + h * 64 + 8 * w);
#pragma unroll
    for (int i2 = 0; i2 < 2; ++i2) { const int id = tid + NTHR * i2, jj = id >> 4, c16 = id & 15; R.v[i2] = *(const v4u*)(Z + (t0 + jj) * ZE + 512 + h * 128 + 8 * c16); }
    if (OUT) {
#pragma unroll
        for (int i2 = 0; i2 < 2; ++i2) { const int id = tid + NTHR * i2, row = id >> 4, c16 = id & 15; R.s[i2] = *(const v4u*)(KV + (size_t)u * 8192 + row * 128 + 8 * c16); }
    }
}
__device__ __forceinline__ float lane_scan(float v, int lane) {
    v += __builtin_bit_cast(float, __builtin_amdgcn_update_dpp(0, __builtin_bit_cast(int, v), 0x111, 0xF, 0xF, true));
    v += __builtin_bit_cast(float, __builtin_amdgcn_update_dpp(0, __builtin_bit_cast(int, v), 0x112, 0xF, 0xF, true));
    v += __builtin_bit_cast(float, __builtin_amdgcn_update_dpp(0, __builtin_bit_cast(int, v), 0x114, 0xF, 0xF, true));
    v += __builtin_bit_cast(float, __builtin_amdgcn_update_dpp(0, __builtin_bit_cast(int, v), 0x118, 0xF, 0xF, true));
    const int x = __builtin_bit_cast(int, v);
    const float t0 = __builtin_bit_cast(float, __builtin_amdgcn_readlane(x, 15)), t1 = __builtin_bit_cast(float, __builtin_amdgcn_readlane(x, 31)), t2 = __builtin_bit_cast(float, __builtin_amdgcn_readlane(x, 47));
    const int r = lane >> 4;
    return v + ((r >= 1) ? t0 : 0.f) + ((r >= 2) ? t1 : 0.f) + ((r >= 3) ? t2 : 0.f);
}
template <bool OUT> __device__ __forceinline__ void gla_prep(Frame& F, const GlaRaw& R, const float* bgate, float* decp) {
    const int tid = F.tid, j = F.lane, w = F.wave;
#pragma unroll
    for (int i2 = 0; i2 < 2; ++i2) { const int id = tid + NTHR * i2, jj = id >> 4, c16 = id & 15; *(LAS v4u*)(F.lds + GL_VT + jj * 288 + c16 * 16) = R.v[i2]; }
    if (OUT) {
#pragma unroll
        for (int i2 = 0; i2 < 2; ++i2) { const int id = tid + NTHR * i2, row = id >> 4, c16 = id & 15; *(LAS v4u*)(F.lds + GL_ST + row * 288 + c16 * 16) = R.s[i2]; }
    }
    const f32x4 bg0 = *(const f32x4*)(bgate + 8 * w), bg1 = *(const f32x4*)(bgate + 8 * w + 4);
    const float bias[8] = {bg0.x, bg0.y, bg0.z, bg0.w, bg1.x, bg1.y, bg1.z, bg1.w};
    float gp[8], kv[8], qv[8]; unpack8(R.gp, gp); unpack8(R.k, kv); unpack8(R.q, qv);
    float ko[8], qo[8];
#pragma unroll
    for (int e = 0; e < 8; ++e) { const float b = lane_scan(flogsigmoid(gp[e] + bias[e]) * (1.0f / 16.0f), j);
        if (OUT) { qo[e] = qv[e] * 0.125f * fexp(b); ko[e] = kv[e] * fexp(-b); }
        else { const float bl = __builtin_bit_cast(float, __builtin_amdgcn_readlane(__builtin_bit_cast(int, b), 63)); ko[e] = kv[e] * fexp(bl - b); qo[e] = fexp(bl); } }
    *(LAS v4u*)(F.lds + GL_KT + j * 160 + w * 16) = pack8(ko);
    if (OUT) *(LAS v4u*)(F.lds + GL_QT + j * 160 + w * 16) = pack8(qo);
    else if (j == 63) { *(f32x4*)(decp + 8 * w) = (f32x4){qo[0], qo[1], qo[2], qo[3]}; *(f32x4*)(decp + 8 * w + 4) = (f32x4){qo[4], qo[5], qo[6], qo[7]}; }
}
__device__ __forceinline__ bf16x8 tr2(const LAS unsigned char* p0, const LAS unsigned char* p1) {
    const s16x4 lo = vtr(p0), hi = vtr(p1); return (bf16x8){lo[0], lo[1], lo[2], lo[3], hi[0], hi[1], hi[2], hi[3]};
}
__device__ __forceinline__ void phase_gla_kv(Frame& F, int i) {
    const bf16* Z = (const bf16*)(F.ws + WS_Z); bf16* KV = (bf16*)(F.ws + WS_X1); float* DEC = (float*)(F.ws + WS_DEC);
    const float* bg = INF(I_EBG) + i * 256;
    const int w = F.wave, c = F.lane & 15, g = F.lane >> 4, kt = w & 3, vt0 = 4 * (w >> 2);
#define GLA_UNIT(k16_, b_, h_, n_, u_, t0_) const int b_ = (int)blockIdx.x >> 5, h_ = (k16_) & 3, n_ = 4 * ((int)blockIdx.x & 31) + ((k16_) >> 2), u_ = ((b_ * 4 + h_) << 7) + n_; const size_t t0_ = (size_t)b_ * SEQ + n_ * 64
    GlaRaw R;
    { GLA_UNIT(0, b0, h0, n0, u0, t00); gla_load<false>(F, Z, nullptr, u0, t00, h0, R); }
    for (int k16 = 0; k16 < 16; ++k16) {
        GLA_UNIT(k16, b, h, n, u, t0);
        __syncthreads();
        gla_prep<false>(F, R, bg + h * 64, DEC + (size_t)u * 64);
        if (k16 < 15) { GLA_UNIT(k16 + 1, b2, h2, n2, u2, t02); gla_load<false>(F, Z, nullptr, u2, t02, h2, R); }
        __syncthreads();
        f32x4 acc[4];
#pragma unroll
        for (int q4 = 0; q4 < 4; ++q4) acc[q4] = (f32x4){0.f, 0.f, 0.f, 0.f};
#pragma unroll
        for (int s = 0; s < 2; ++s) { const int row0 = 32 * s + 8 * g + (c >> 2);
            const bf16x8 A = tr2(F.lds + GL_KT + row0 * 160 + (16 * kt + 4 * (c & 3)) * 2, F.lds + GL_KT + (row0 + 4) * 160 + (16 * kt + 4 * (c & 3)) * 2);
#pragma unroll
            for (int q4 = 0; q4 < 4; ++q4) { const int vt = vt0 + q4;
                const bf16x8 Bf = tr2(F.lds + GL_VT + row0 * 288 + (16 * vt + 4 * (c & 3)) * 2, F.lds + GL_VT + (row0 + 4) * 288 + (16 * vt + 4 * (c & 3)) * 2);
                acc[q4] = __builtin_amdgcn_mfma_f32_16x16x32_bf16(Bf, A, acc[q4], 0, 0, 0); } }
#pragma unroll
        for (int q4 = 0; q4 < 4; ++q4) { v2u o; o.x = pk2(acc[q4][0], acc[q4][1]); o.y = pk2(acc[q4][2], acc[q4][3]);
            *(v2u*)(KV + ((size_t)u * 64 + 16 * kt + c) * 128 + 16 * (vt0 + q4) + 4 * g) = o; }
    }
}
__device__ __forceinline__ void phase_gla_scan(Frame& F) {
    bf16* KV = (bf16*)(F.ws + WS_X1); const float* DEC = (const float*)(F.ws + WS_DEC);
    for (int gt = blockIdx.x * NTHR + F.tid; gt < 32 * 4096; gt += F.G * NTHR) {
        const int bh = gt >> 12, e2 = gt & 4095, k = e2 >> 6;
        unsigned* p = (unsigned*)(KV + (size_t)bh * 128 * 8192 + 2 * e2); const float* dp = DEC + (size_t)bh * 128 * 64 + k;
        float s0 = 0.f, s1 = 0.f;
#pragma unroll 16
        for (int n = 0; n < 128; ++n) { const unsigned kvw = p[(size_t)n * 4096]; const float d = dp[n * 64];
            p[(size_t)n * 4096] = pk2(s0, s1); s0 = s0 * d + bflo(kvw); s1 = s1 * d + bfhi(kvw); }
    }
}
__device__ __forceinline__ void phase_gla_out(Frame& F, int i) {
    const bf16* Z = (const bf16*)(F.ws + WS_Z); const bf16* KV = (const bf16*)(F.ws + WS_X1); bf16* MIX = (bf16*)(F.ws + WS_M);
    const float* bg = INF(I_EBG) + i * 256; const float* gng = INF(I_EGNG) + i * 128;
    const int tid = F.tid, w = F.wave, c = F.lane & 15, g = F.lane >> 4, I = w & 3, vt0 = 4 * (w >> 2);
    LAS float* ssq = (LAS float*)(F.lds + GL_SSQ);
    GlaRaw R;
    { GLA_UNIT(0, b0, h0, n0, u0, t00); gla_load<true>(F, Z, KV, u0, t00, h0, R); }
    for (int k16 = 0; k16 < 16; ++k16) {
        GLA_UNIT(k16, b, h, n, u, t0);
        v4u gvr[2];
#pragma unroll
        for (int i2 = 0; i2 < 2; ++i2) { const int id = tid + NTHR * i2, jj = id >> 4, c16 = id & 15; gvr[i2] = *(const v4u*)(Z + (t0 + jj) * ZE + 1024 + h * 128 + 8 * c16); }
        __syncthreads();
        gla_prep<true>(F, R, bg + h * 64, nullptr);
        if (k16 < 15) { GLA_UNIT(k16 + 1, b2, h2, n2, u2, t02); gla_load<true>(F, Z, KV, u2, t02, h2, R); }
        __syncthreads();
        bf16x8 qf[2];
#pragma unroll
        for (int s = 0; s < 2; ++s) qf[s] = *(const LAS bf16x8*)(F.lds + GL_QT + (16 * I + c) * 160 + (32 * s + 8 * g) * 2);
        f32x4 P[4];
#pragma unroll
        for (int J = 0; J < 4; ++J) { P[J] = (f32x4){0.f, 0.f, 0.f, 0.f};
            if (J <= I) { const bf16x8 k0 = *(const LAS bf16x8*)(F.lds + GL_KT + (16 * J + c) * 160 + (8 * g) * 2), k1 = *(const LAS bf16x8*)(F.lds + GL_KT + (16 * J + c) * 160 + (32 + 8 * g) * 2);
                f32x4 z = {0.f, 0.f, 0.f, 0.f}; z = __builtin_amdgcn_mfma_f32_16x16x32_bf16(k0, qf[0], z, 0, 0, 0); z = __builtin_amdgcn_mfma_f32_16x16x32_bf16(k1, qf[1], z, 0, 0, 0);
                if (J == I) {
#pragma unroll
                    for (int r = 0; r < 4; ++r) z[r] = (4 * g + r <= c) ? z[r] : 0.f; }
                P[J] = z; } }
        bf16x8 pa[2];
#pragma unroll
        for (int p = 0; p < 2; ++p) { v4u t; t.x = pk2(P[2 * p][0], P[2 * p][1]); t.y = pk2(P[2 * p][2], P[2 * p][3]); t.z = pk2(P[2 * p + 1][0], P[2 * p + 1][1]); t.w = pk2(P[2 * p + 1][2], P[2 * p + 1][3]);
            pa[p] = __builtin_bit_cast(bf16x8, t); }
        f32x4 acc[4];
#pragma unroll
        for (int q4 = 0; q4 < 4; ++q4) { const int vt = vt0 + q4; const int cb = (16 * vt + 4 * (c & 3)) * 2;
            f32x4 a = {0.f, 0.f, 0.f, 0.f};
#pragma unroll
            for (int s = 0; s < 2; ++s) { const int row0 = 32 * s + 8 * g + (c >> 2);
                a = __builtin_amdgcn_mfma_f32_16x16x32_bf16(qf[s], tr2(F.lds + GL_ST + row0 * 288 + cb, F.lds + GL_ST + (row0 + 4) * 288 + cb), a, 0, 0, 0); }
#pragma unroll
            for (int p = 0; p < 2; ++p) if (2 * p <= I) { const int rA = 32 * p + 4 * g + (c >> 2);
                a = __builtin_amdgcn_mfma_f32_16x16x32_bf16(pa[p], tr2(F.lds + GL_VT + rA * 288 + cb, F.lds + GL_VT + (rA + 16) * 288 + cb), a, 0, 0, 0); }
            acc[q4] = a; }
#pragma unroll
        for (int r = 0; r < 4; ++r) { float s = 0.f;
#pragma unroll
            for (int q4 = 0; q4 < 4; ++q4) s += acc[q4][r] * acc[q4][r];
            s += swz_xor<1>(s); s += swz_xor<2>(s); s += swz_xor<4>(s); s += swz_xor<8>(s);
            if (c == 0) ssq[(w >> 2) * 64 + 16 * I + 4 * g + r] = s; }
        __syncthreads();
#pragma unroll
        for (int r = 0; r < 4; ++r) { const int row = 16 * I + 4 * g + r;
            const float rstd = __builtin_amdgcn_rsqf((ssq[row] + ssq[64 + row]) * (1.0f / 128.0f) + NORM_EPS);
#pragma unroll
            for (int q4 = 0; q4 < 4; ++q4) { const int col = 16 * (vt0 + q4) + c;
                *(LAS unsigned short*)(F.lds + GL_ST + row * 272 + col * 2) = (unsigned short)f2bf(acc[q4][r] * rstd * gng[col]); } }
        __syncthreads();
#pragma unroll
        for (int i2 = 0; i2 < 2; ++i2) { const int id = tid + NTHR * i2, jj = id >> 4, c16 = id & 15;
            const v4u ov = *(const LAS v4u*)(F.lds + GL_ST + jj * 272 + c16 * 16), gv = gvr[i2];
            float o[8], gg[8]; unpack8(ov, o); unpack8(gv, gg);
#pragma unroll
            for (int e = 0; e < 8; ++e) o[e] *= fsilu(gg[e]);
            *(v4u*)(MIX + (t0 + jj) * D + h * 128 + 8 * c16) = pack8(o); }
    }
}
__device__ __forceinline__ void phase_conv(Frame& F, int i) {
    const bf16* Z = (const bf16*)(F.ws + WS_Z); bf16* MIX = (bf16*)(F.ws + WS_M);
    LAS float* glu = (LAS float*)(F.lds + 0);
    LAS float* red = (LAS float*)(F.lds + 126976);
    LAS float* stat = (LAS float*)(F.lds + 128000);
    const int tid = F.tid, half = tid >> 8, cp = tid & 255;
    f32x2 wv[31];
    { const float* cw = INF(I_ECW) + (size_t)i * 31 * 512 + 2 * cp;
#pragma unroll
        for (int w = 0; w < 31; ++w) wv[w] = *(const f32x2*)(cw + w * 512); }
    const f32x2 cb = *(const f32x2*)(INF(I_ECB) + i * 512 + 2 * cp), lg = *(const f32x2*)(INF(I_ELNG) + i * 512 + 2 * cp), lb = *(const f32x2*)(INF(I_ELNB) + i * 512 + 2 * cp);
    for (int k8 = 0; k8 < 8; ++k8) {
        const int u = (int)blockIdx.x * 8 + k8; const int b = u >> 8, s0 = (u & 255) * 32; const size_t t0 = (size_t)b * SEQ + s0;
        __syncthreads();
#pragma unroll
        for (int it = 0; it < 8; ++it) { const int id = tid + NTHR * it;
            if (id < 62 * 64) { const int r = id >> 6, c8 = id & 63, s = s0 - 30 + r;
                float gl[8];
#pragma unroll
                for (int e = 0; e < 8; ++e) gl[e] = 0.f;
                if (s >= 0) { const bf16* zr = Z + ((size_t)b * SEQ + s) * ZE; const v4u av = *(const v4u*)(zr + 1792 + 8 * c8);
                    unpack8(av, gl); }
                *(LAS f32x4*)(glu + r * 512 + 8 * c8) = (f32x4){gl[0], gl[1], gl[2], gl[3]}; *(LAS f32x4*)(glu + r * 512 + 8 * c8 + 4) = (f32x4){gl[4], gl[5], gl[6], gl[7]}; } }
        __syncthreads();
        f32x2 y[16];
#pragma unroll
        for (int tt = 0; tt < 16; ++tt) y[tt] = cb;
#pragma unroll
        for (int r = 0; r < 46; ++r) { const f32x2 gv = *(const LAS f32x2*)(glu + (16 * half + r) * 512 + 2 * cp);
#pragma unroll
            for (int tt = 0; tt < 16; ++tt) if (r - tt >= 0 && r - tt <= 30) y[tt] += gv * wv[r - tt]; }
#pragma unroll
        for (int tt = 0; tt < 16; ++tt) { const float s1 = wave_sum(y[tt].x + y[tt].y), s2 = wave_sum(y[tt].x * y[tt].x + y[tt].y * y[tt].y);
            if (F.lane == 0) { red[(F.wave * 16 + tt) * 2] = s1; red[(F.wave * 16 + tt) * 2 + 1] = s2; } }
        __syncthreads();
        if (tid < 32) { const int hf = tid >> 4, tt = tid & 15; float s1 = 0.f, s2 = 0.f;
#pragma unroll
            for (int w = 0; w < 4; ++w) { s1 += red[((4 * hf + w) * 16 + tt) * 2]; s2 += red[((4 * hf + w) * 16 + tt) * 2 + 1]; }
            const float mean = s1 * (1.0f / 512.0f); const float var = fmaxf(s2 * (1.0f / 512.0f) - mean * mean, 0.f);
            stat[2 * tid] = mean; stat[2 * tid + 1] = __builtin_amdgcn_rsqf(var + NORM_EPS); }
        __syncthreads();
#pragma unroll
        for (int tt = 0; tt < 16; ++tt) { const float mean = stat[2 * (16 * half + tt)], rstd = stat[2 * (16 * half + tt) + 1];
            const f32x2 o = (y[tt] - mean) * rstd * lg + lb;
            *(unsigned*)(MIX + (t0 + 16 * half + tt) * D + 512 + 2 * cp) = pk2(fsilu(o.x), fsilu(o.y)); }
    }
}

#define ATT_DECODE(uu, br, b, h, r, nb, d) do { const int bh_ = (uu) / (64 * nbr), k_ = (uu) - bh_ * (64 * nbr); br = br_lo + (k_ >> 6); const int wi_ = k_ & 63; b = bh_ >> 4; h = bh_ & 15; \
        d = (br == 0) ? 1 : (br == 1 ? 4 : 16); r = wi_ & (d - 1); nb = wi_ / d; } while (0)
#define ATT_LOADKV(kr, vr, b, h, r, nb, d) do { const int pb_ = (nb) > 0 ? (nb) - 1 : 0; _Pragma("unroll") for (int i_ = 0; i_ < 4; ++i_) { const int id_ = tid + NTHR * i_, row_ = id_ >> 3, ch_ = id_ & 7; \
        const int lk_ = 128 * ((i_ < 2) ? pb_ : (nb)) + (row_ & 127); \
        const size_t o_ = ((size_t)((b) * 16 + (h)) * SEQ + (r) + (size_t)(d) * lk_) * 64 + ch_ * 8; kr[i_] = *(const v4u*)(Z + (size_t)T * 1024 + o_); vr[i_] = *(const v4u*)(Z + (size_t)2 * T * 1024 + o_); } } while (0)
#define ATT_STOREKV(kr, vr, buf) do { _Pragma("unroll") for (int i_ = 0; i_ < 4; ++i_) { const int id_ = tid + NTHR * i_, row_ = id_ >> 3, ch_ = id_ & 7; \
        *(LAS v4u*)(F.lds + (buf) * 73728 + row_ * 144 + ch_ * 16) = kr[i_]; *(LAS v4u*)(F.lds + (buf) * 73728 + 36864 + row_ * 144 + ch_ * 16) = vr[i_]; } } while (0)
template <bool MERGE> __device__ __forceinline__ void phase_attn(Frame& F, const int br_lo, const int nbr) {
    const bf16* Z = (const bf16*)(F.ws + WS_Z);
    const int tid = F.tid, lane = F.lane, w = F.wave, c = lane & 15, g = lane >> 4;
    const int per_x = nbr * 1024, x = F.vcu >> 5, cu = F.vcu & 31, nit = per_x >> 5;
    const float* L = (const float*)(F.ws + WS_LSE);
    f32x4 m0, m8;
#pragma unroll
    for (int i = 0; i < 4; ++i) { m0[i] = (4 * g + i >= c) ? 0.f : -1.0e38f; m8[i] = (4 * g + i <= c) ? 0.f : -1.0e38f; }
    v4u kr[4], vr[4];
    int br, b, h, r, nb, d;
    { const int uu = x * per_x + cu; ATT_DECODE(uu, br, b, h, r, nb, d); }
    __syncthreads();
    ATT_LOADKV(kr, vr, b, h, r, nb, d);
    size_t tq = (size_t)b * SEQ + r + (size_t)d * (128 * nb + 16 * w + c);
    bf16x8 q0 = *(const bf16x8*)(Z + ((size_t)(b * 16 + h) * SEQ + (tq & 8191)) * 64 + 8 * g), q1 = *(const bf16x8*)(Z + ((size_t)(b * 16 + h) * SEQ + (tq & 8191)) * 64 + 32 + 8 * g);
    ATT_STOREKV(kr, vr, 0);
    __syncthreads();
    for (int it = 0; it < nit; ++it) {
        const int cur = it & 1;
        int br2 = 0, b2 = 0, h2 = 0, r2 = 0, nb2 = 0, d2 = 1;
        const bool has_next = (it + 1 < nit);
        size_t tq2 = 0; bf16x8 qn0 = q0, qn1 = q1;
        if (has_next) { const int uu = x * per_x + 32 * (it + 1) + cu; ATT_DECODE(uu, br2, b2, h2, r2, nb2, d2); ATT_LOADKV(kr, vr, b2, h2, r2, nb2, d2);
            tq2 = (size_t)b2 * SEQ + r2 + (size_t)d2 * (128 * nb2 + 16 * w + c);
            qn0 = *(const bf16x8*)(Z + ((size_t)(b2 * 16 + h2) * SEQ + (tq2 & 8191)) * 64 + 8 * g); qn1 = *(const bf16x8*)(Z + ((size_t)(b2 * 16 + h2) * SEQ + (tq2 & 8191)) * 64 + 32 + 8 * g); }
        LAS unsigned char* Ks = F.lds + cur * 73728; LAS unsigned char* Vs = Ks + 36864;
        v2u o1[4], o2[4]; float l1 = 0.f, l2 = 0.f;
        if (MERGE) {
            const bf16* O1 = (const bf16*)(F.ws + WS_H); const bf16* O2 = (const bf16*)(F.ws + WS_X1);
#pragma unroll
            for (int dt = 0; dt < 4; ++dt) { o1[dt] = __builtin_nontemporal_load((const v2u*)(O1 + tq * D + h * 64 + 16 * dt + 4 * g)); o2[dt] = __builtin_nontemporal_load((const v2u*)(O2 + tq * D + h * 64 + 16 * dt + 4 * g)); }
            l1 = L[tq * 16 + h]; l2 = L[(size_t)T * 16 + tq * 16 + h];
        }
        f32x4 S[9];
        {
            bf16x8 kf[9][2];
#pragma unroll
            for (int kt = 0; kt < 9; ++kt) { const int row = 16 * w + 16 * kt + c;
                kf[kt][0] = *(const LAS bf16x8*)(Ks + row * 144 + g * 16); kf[kt][1] = *(const LAS bf16x8*)(Ks + row * 144 + 64 + g * 16); }
            __builtin_amdgcn_sched_barrier(0);
#pragma unroll
            for (int kt = 0; kt < 9; ++kt) { f32x4 z = (f32x4){0.f, 0.f, 0.f, 0.f};
                if (kt == 0) z = m0; else if (kt == 8) z = m8;
                z = __builtin_amdgcn_mfma_f32_16x16x32_bf16(kf[kt][0], q0, z, 0, 0, 0); S[kt] = __builtin_amdgcn_mfma_f32_16x16x32_bf16(kf[kt][1], q1, z, 0, 0, 0); }
            if (nb == 0) { asm volatile("" ::: "memory");
#pragma unroll
                for (int kt = 0; kt < 8; ++kt) if (kt < 8 - w) S[kt] = S[kt] + -1.0e38f; }
        }
        bf16x8 vf[5][4];
#pragma unroll
        for (int sp = 0; sp < 5; ++sp) { const int kt0 = 2 * sp, kt1 = (sp < 4) ? 2 * sp + 1 : 8;
            const int rowA = 16 * w + 16 * kt0 + 4 * g + (c >> 2), rowB = 16 * w + 16 * kt1 + 4 * g + (c >> 2);
#pragma unroll
            for (int dt = 0; dt < 4; ++dt) vf[sp][dt] = tr2(Vs + rowA * 144 + (16 * dt + 4 * (c & 3)) * 2, Vs + rowB * 144 + (16 * dt + 4 * (c & 3)) * 2); }
        __builtin_amdgcn_sched_barrier(0);
        float m = -1.0e38f;
#pragma unroll
        for (int kt = 0; kt < 9; ++kt) { m = __builtin_fmaxf(__builtin_fmaxf(m, S[kt][0]), S[kt][1]); m = __builtin_fmaxf(__builtin_fmaxf(m, S[kt][2]), S[kt][3]); }
        m = rows4_max(m);
        typedef float f32x2_ __attribute__((ext_vector_type(2)));
        const f32x2_ m2 = {m, m}; f32x2_ lsum2 = {0.f, 0.f};
#pragma unroll
        for (int kt = 0; kt < 9; ++kt) {
            const f32x2_ a = S[kt].lo - m2, b2_ = S[kt].hi - m2;
            f32x2_ pa, pb; pa.x = __builtin_amdgcn_exp2f(a.x); pa.y = __builtin_amdgcn_exp2f(a.y); pb.x = __builtin_amdgcn_exp2f(b2_.x); pb.y = __builtin_amdgcn_exp2f(b2_.y);
            lsum2 = lsum2 + pa; lsum2 = lsum2 + pb; S[kt].lo = pa; S[kt].hi = pb; }
        float l = lsum2.x + lsum2.y;
        l = rows4_sum(l);
        f32x4 O[4];
#pragma unroll
        for (int dt = 0; dt < 4; ++dt) O[dt] = (f32x4){0.f, 0.f, 0.f, 0.f};
#pragma unroll
        for (int sp = 0; sp < 5; ++sp) {
            const int kt0 = 2 * sp, kt1 = (sp < 4) ? 2 * sp + 1 : 8;
            v4u pbu; pbu.x = pk2(S[kt0][0], S[kt0][1]); pbu.y = pk2(S[kt0][2], S[kt0][3]);
            if (sp < 4) { pbu.z = pk2(S[kt1][0], S[kt1][1]); pbu.w = pk2(S[kt1][2], S[kt1][3]); } else { pbu.z = 0u; pbu.w = 0u; }
            const bf16x8 pb = __builtin_bit_cast(bf16x8, pbu);
#pragma unroll
            for (int dt = 0; dt < 4; ++dt) O[dt] = __builtin_amdgcn_mfma_f32_16x16x32_bf16(vf[sp][dt], pb, O[dt], 0, 0, 0);
        }
        const float inv = frcp(l); const float lse = (m + __builtin_amdgcn_logf(l)) * LN2;
        if (MERGE) {
            const float mx = fmaxf(lse, fmaxf(l1, l2)); float w1 = fexp(l1 - mx), w2 = fexp(l2 - mx), w3 = fexp(lse - mx); const float wi = frcp(w1 + w2 + w3); w1 *= wi; w2 *= wi; w3 *= wi * inv;
            bf16* OUT = (bf16*)(F.ws + WS_M);
#pragma unroll
            for (int dt = 0; dt < 4; ++dt) { v2u o;
                o.x = pk2(w1 * bflo(o1[dt].x) + w2 * bflo(o2[dt].x) + w3 * O[dt][0], w1 * bfhi(o1[dt].x) + w2 * bfhi(o2[dt].x) + w3 * O[dt][1]);
                o.y = pk2(w1 * bflo(o1[dt].y) + w2 * bflo(o2[dt].y) + w3 * O[dt][2], w1 * bfhi(o1[dt].y) + w2 * bfhi(o2[dt].y) + w3 * O[dt][3]);
                *(v2u*)(OUT + tq * D + h * 64 + 16 * dt + 4 * g) = o; }
        } else {
            bf16* Obr = (bf16*)(F.ws + (br == 0 ? WS_X1 + 64 * MiB : (br == 1 ? WS_X1 : WS_M))); float* Lbr     = (float*)(F.ws + WS_LSE) + (size_t)br * T * 16;
            {
                unsigned char* Ob8 = (unsigned char*)Obr; const float sc_ = inv * 64.0f; v4u o;
                o.x = pk4_fp8(O[0][0] * sc_, O[0][1] * sc_, O[0][2] * sc_, O[0][3] * sc_); o.y = pk4_fp8(O[1][0] * sc_, O[1][1] * sc_, O[1][2] * sc_, O[1][3] * sc_);
                o.z = pk4_fp8(O[2][0] * sc_, O[2][1] * sc_, O[2][2] * sc_, O[2][3] * sc_); o.w = pk4_fp8(O[3][0] * sc_, O[3][1] * sc_, O[3][2] * sc_, O[3][3] * sc_);
                if (br == 2) *(v4u*)(Ob8 + tq * D + h * 64 + 16 * g) = o; else __builtin_nontemporal_store(o, (v4u*)(Ob8 + tq * D + h * 64 + 16 * g)); }
            if (g == 0) Lbr[tq * 16 + h] = lse;
        }
        __builtin_amdgcn_sched_barrier(0);
        if (has_next) ATT_STOREKV(kr, vr, cur ^ 1);
        __syncthreads();
        br = br2; b = b2; h = h2; r = r2; nb = nb2; d = d2; tq = tq2; q0 = qn0; q1 = qn1;
    }
}
#undef ATT_DECODE
#undef ATT_LOADKV
#undef ATT_STOREKV
__device__ __forceinline__ void phase_attn_merge(Frame& F) {
    const int gw = blockIdx.x * NWAVES + F.wave; const int lane = F.lane;
    const unsigned char* O1 = F.ws + WS_X1 + 64 * MiB; const unsigned char* O2 = F.ws + WS_X1; const unsigned char* O3 = F.ws + WS_M;
    unsigned char* OUT8 = F.ws + WS_M8;
    const float* L = (const float*)(F.ws + WS_LSE);
    typedef float f32x2_ __attribute__((ext_vector_type(2)));
    for (int r = 0; r < 32; r += 2) {
        unsigned a[2][4], bq[2][4], cq[2][4]; float l1[2][4], l2[2][4], l3[2][4];
#pragma unroll
        for (int p = 0; p < 2; ++p) { const size_t t = (size_t)gw * 32 + r + p;
#pragma unroll
            for (int j = 0; j < 4; ++j) { const int c = 256 * j + 4 * lane, hd = c >> 6;
                a[p][j] = __builtin_nontemporal_load((const unsigned*)(O1 + t * D + c)); bq[p][j] = __builtin_nontemporal_load((const unsigned*)(O2 + t * D + c)); cq[p][j] = *(const unsigned*)(O3 + t * D + c);
                l1[p][j] = L[t * 16 + hd]; l2[p][j] = L[(size_t)T * 16 + t * 16 + hd]; l3[p][j] = L[(size_t)2 * T * 16 + t * 16 + hd]; } }
#pragma unroll
        for (int p = 0; p < 2; ++p) { const size_t t = (size_t)gw * 32 + r + p;
#pragma unroll
            for (int j = 0; j < 4; ++j) { const int c = 256 * j + 4 * lane;
                const float mx = fmaxf(l1[p][j], fmaxf(l2[p][j], l3[p][j])); float w1 = fexp(l1[p][j] - mx), w2 = fexp(l2[p][j] - mx), w3 = fexp(l3[p][j] - mx); const float inv = frcp(w1 + w2 + w3) * 0.5f; w1 *= inv; w2 *= inv; w3 *= inv;
                const f32x2_ a0 = __builtin_amdgcn_cvt_pk_f32_fp8((int)a[p][j], false), a1 = __builtin_amdgcn_cvt_pk_f32_fp8((int)a[p][j], true), b0 = __builtin_amdgcn_cvt_pk_f32_fp8((int)bq[p][j], false), b1 = __builtin_amdgcn_cvt_pk_f32_fp8((int)bq[p][j], true),
                            c0 = __builtin_amdgcn_cvt_pk_f32_fp8((int)cq[p][j], false), c1 = __builtin_amdgcn_cvt_pk_f32_fp8((int)cq[p][j], true);
                *(unsigned*)(OUT8 + t * D + c) = pk4_fp8(w1 * a0.x + w2 * b0.x + w3 * c0.x, w1 * a0.y + w2 * b0.y + w3 * c0.y, w1 * a1.x + w2 * b1.x + w3 * c1.x, w1 * a1.y + w2 * b1.y + w3 * c1.y); } }
    }
}

struct Args { const void* in[26]; float* out; unsigned char* ws; int pad0, pad1; };
__global__ void __launch_bounds__(NTHR, 2) mk_fwd(Args args) {
    extern __shared__ __attribute__((aligned(16))) unsigned char lds_raw[];
    Frame F;
    F.lds = (LAS unsigned char*)lds_raw;
    F.tid = threadIdx.x; F.lane = F.tid & 63; F.wave = __builtin_amdgcn_readfirstlane(F.tid >> 6);
    F.G = gridDim.x; { const int bx = blockIdx.x; F.vcu = (F.G % 8 == 0) ? (bx % 8) * (F.G / 8) + bx / 8 : bx; }
    F.ws = args.ws; F.out = args.out; F.ctl = (gu32*)(args.ws + WS_CTL);
    volatile LAS unsigned* MISC = (volatile LAS unsigned*)(F.lds + LDS_MISC);
    if (F.tid < 64) MISC[F.tid] = 0u;
    __syncthreads();
    XcdBarrier bar = xcd_barrier_post((unsigned*)(F.ctl + CW_BAR), MISC);
    const int wave_s = F.wave;
#define FRESH() do { int w_ = wave_s; asm volatile("" : "+s"(w_)); int t_; asm volatile("v_mbcnt_lo_u32_b32 %0, -1, 0\n\tv_mbcnt_hi_u32_b32 %0, -1, %0" : "=v"(t_)); t_ += w_ * 64; F.tid = t_; F.lane = t_ & 63; F.wave = w_; int v_ = F.vcu; asm volatile("" : "+s"(v_)); F.vcu = v_; } while (0)
#define SEAM() do { XcdBarrier b_ = bar; asm volatile("" : "+s"(b_.x), "+s"(b_.bar)); int w_ = wave_s; asm volatile("" : "+s"(w_)); int t_; asm volatile("v_mbcnt_lo_u32_b32 %0, -1, 0\n\tv_mbcnt_hi_u32_b32 %0, -1, %0" : "=v"(t_)); xcd_barrier(b_, (t_ + w_ * 64) == 0); } while (0)
#ifndef MK_OFF
#define MK_OFF 0
#endif
#define ON(n) (!(((MK_OFF) >> (n)) & 1))
#ifndef MK_REP
#define MK_REP 0
#endif
#define NREP(n) ((((MK_REP) >> (n)) & 1) ? 2 : 1)
#define PROBE(n) (((MK_REP) >> (n)) & 1)
    bf16* const H = (bf16*)(F.ws + WS_H); bf16* const M_ = (bf16*)(F.ws + WS_M); bf16* const Z = (bf16*)(F.ws + WS_Z); bf16* const HID = (bf16*)(F.ws + WS_HID);

    if (ON(0)) for (int rep = 0; rep < NREP(0); ++rep) { FRESH(); phase_prologue(F); FRESH(); convert_moe(F, 0); }
    SEAM();
    for (int l = 0; l < DEPTH; ++l) {
        const int i = l >> 1; const bool odd = (l & 1) != 0;
#if defined(MK_SLEEP_US)
        for (int s_ = 0; s_ < (MK_SLEEP_US) / 4; ++s_) __builtin_amdgcn_s_sleep(127);
#endif
        if (ON(1)) { FRESH(); if (l > 0) for (int rep = 0; rep < NREP(1); ++rep) convert_moe(F, l); for (int rep = PROBE(16) ? 0 : 1; rep < 2; ++rep) { FRESH(); phase_n1(F, l, rep == 1 ? 1.0f : 0.0f); } }
        __syncthreads();
        for (int rep = 0; rep < NREP(2); ++rep) { FRESH();
            if (ON(2) && !odd) { pg8::Gemm g{H, (const bf16*)(F.ws + WS_WIN) + (size_t)i * ZEW * 1024, T, ZEW, 1024}; pg8::PanelOrder S{(int)blockIdx.x, ZEW / 256};
                pg8::EpiZe E{Z, ZE};
                pg8::gemm_phase<pg8::EpiZe, pg8::PanelOrder, true, true>(F.lds, g, S, E, F.wave); }
            else if (ON(3)) { pg8::Gemm g{H, (const bf16*)(F.ws + WS_WQKV + (size_t)i * ZO * 1024), T, ZO, 512}; pg8::PanelOrder S{(int)blockIdx.x, ZO / 256};
                { const f32x4* csg = (const f32x4*)(F.ws + WS_CS) + (size_t)blockIdx.x * 256 * 4; LAS f32x4* csl = (LAS f32x4*)(F.lds + LDS_CSROWS);
                  for (int q_ = F.tid; q_ < 256 * 4; q_ += NTHR) csl[q_] = csg[q_]; }
                pg8::EpiQkv E{Z, ZO, (const LAS float*)(F.lds + LDS_CSROWS), 1.0f / W8_SCALE};
                pg8::gemm_phase<pg8::EpiQkv, pg8::PanelOrder, true, true, false, true>(F.lds, g, S, E, F.wave); }
        }
        if (!odd) {
            __syncthreads();
            if (ON(4)) for (int rep = 0; rep < NREP(3); ++rep) { FRESH(); phase_gla_kv(F, i); }
            SEAM();
            if (ON(5)) { FRESH(); phase_gla_scan(F); }
            SEAM();
            { FRESH(); if (ON(6)) for (int rep = 0; rep < NREP(6); ++rep) phase_gla_out(F, i); if (ON(7)) for (int rep = 0; rep < NREP(7); ++rep) phase_conv(F, i); }
            __syncthreads();
        } else {
            SEAM();
            if (ON(8)) for (int rep = 0; rep < NREP(4); ++rep) { FRESH(); phase_attn<false>(F, 0, 3); }
            SEAM();
            if (ON(9)) { FRESH(); phase_attn_merge(F); }
            __syncthreads();
        }
        if (ON(10)) for (int rep = 0; rep < NREP(8); ++rep) { FRESH();
            pg8::PanelOrder S{(int)blockIdx.x, 4};
            if (!odd) { pg8::Gemm g{M_, (const bf16*)(F.ws + WS_WOE) + (size_t)i * 1024 * 1024, T, 1024, 1024}; pg8::EpiStore E{H, 1024, 4, 1.0f};
                pg8::gemm_phase<pg8::EpiStore, pg8::PanelOrder, true, true>(F.lds, g, S, E, F.wave); }
            else { pg8::Gemm g{(const bf16*)(F.ws + WS_M8), (const bf16*)(F.ws + WS_WOO + (size_t)i * 1024 * 1024), T, 1024, 512}; pg8::EpiStoreT<false, true> E{H, 1024, 4, 1.0f / (W8_SCALE * 32.0f)};
                pg8::gemm_phase<pg8::EpiStoreT<false, true>, pg8::PanelOrder, true, true, false, true>(F.lds, g, S, E, F.wave); }
        }
        __syncthreads();
        if (ON(11)) { FRESH(); for (int rep = PROBE(17) ? 0 : 1; rep < 2; ++rep) { FRESH(); phase_n2(F, l, rep == 0); __syncthreads(); } }
        SEAM();
        if (ON(13)) for (int rep = 0; rep < NREP(9); ++rep) { FRESH();
            build_tstart(F, l);
            pg8::Gemm g{(const bf16*)(F.ws + WS_H8), (const bf16*)(F.ws + WS_W13), PMAX, 1024, 512};
            pg8::GroupOrder S{(const LAS int*)(F.lds + LDS_TAB), F.G, F.vcu, CAPE};
            pg8::EpiSwiglu E{HID, 1.0f / W8_SCALE};
            pg8::gemm_phase<pg8::EpiSwiglu, pg8::GroupOrder, true, true, true, true>(F.lds, g, S, E, F.wave, (const int*)(F.ws + WS_EXPTOK), (unsigned)T);
        }
        SEAM();
        if (ON(14)) for (int rep = 0; rep < NREP(10); ++rep) { FRESH();
            build_tstart(F, l);
            int k2_ = 256; asm volatile("" : "+s"(k2_));
            pg8::Gemm g{HID, (const bf16*)(F.ws + WS_W2), PMAX, 1024, k2_}; pg8::GroupOrder S{(const LAS int*)(F.lds + LDS_TAB), F.G, F.vcu, CAPE};
            pg8::EpiStoreDn E{F.ws + WS_YS};
            pg8::gemm_phase<pg8::EpiStoreDn, pg8::GroupOrder, true, true, false, true>(F.lds, g, S, E, F.wave);
        }
        SEAM();
    }
    if (ON(15)) { FRESH(); phase_n1(F, DEPTH); }
#undef SEAM
}

extern "C" void kernel_launch(void* const* d_in, const int* in_sizes, int n_in, void* d_out, int out_size, void* d_ws, size_t ws_size, hipStream_t stream) {
    static int grid = 0;
    if (grid == 0) {
        if (n_in != 26 || out_size != T * D || ws_size < WS_END) { fprintf(stderr, "kernel_launch: unexpected problem (n_in %d, out %d, ws %zu < %zu); nothing launched\n", n_in, out_size, ws_size, (size_t)WS_END); grid = -1; return; }
        if (hipFuncSetAttribute((const void*)mk_fwd, hipFuncAttributeMaxDynamicSharedMemorySize, LDS_BYTES) != hipSuccess) { fprintf(stderr, "kernel_launch: hipFuncSetAttribute failed\n"); grid = -1; return; }
        int per_cu = 0;
        if (hipOccupancyMaxActiveBlocksPerMultiprocessor(&per_cu, (const void*)mk_fwd, NTHR, LDS_BYTES) != hipSuccess || per_cu < 1) fprintf(stderr, "kernel_launch: occupancy query reports %d\n", per_cu);
        (void)hipGetLastError();
        grid = 256;
    }
    if (grid < 0) return;
    if (hipMemsetAsync((char*)d_ws + WS_CTL, 0, CTL_ZERO_BYTES, stream) != hipSuccess) { fprintf(stderr, "kernel_launch: memset failed\n"); return; }
    Args a{};
    for (int i = 0; i < 26; ++i) a.in[i] = d_in[i];
    a.out = (float*)d_out; a.ws = (unsigned char*)d_ws;
    hipLaunchKernelGGL(mk_fwd, dim3(grid), dim3(NTHR), LDS_BYTES, stream, a);
    const hipError_t le = hipPeekAtLastError();
    if (le != hipSuccess) fprintf(stderr, "kernel_launch: launch failed: %s\n", hipGetErrorName(le));
}
```
